# Optimizing an MI355X kernel written in HIP

```python
import math
import jax, jax.numpy as jnp
from jax import lax
import numpy as np

D_MODEL = 1024
BATCH = 2
SEQ = 8192
DEPTH = 2

CHUNK = 64
Q_BLOCK = 128
ROPE_THETA = 10000.0
RMS_EPS = 1e-6
D_FF = 2816

DA_HEADS = 4
DA_HEAD_DIM = 64
DA_V_DIM = 2 * DA_HEAD_DIM
DA_WIDTH = DA_HEADS * DA_V_DIM

ML_HEADS = 4
ML_QK_DIM = 64
ML_V_DIM = 128
ML_WIDTH = ML_HEADS * ML_V_DIM
ML_CONV = 4
ML_QK_COLS = 2 * ML_HEADS * ML_QK_DIM

MIX_WIDTH = DA_WIDTH + ML_WIDTH

COLS = (DA_HEADS * 2 * DA_HEAD_DIM, DA_HEADS * 2 * DA_HEAD_DIM, DA_WIDTH,
        ML_QK_COLS, ML_WIDTH, ML_WIDTH, 2 * ML_HEADS)
SPLIT_IDX = tuple(int(s) for s in np.cumsum(COLS)[:-1])
IN_COLS = int(sum(COLS))

kernel_name = 'hybrid_diffattn_mlstm_macaron'


def _rmsnorm(x, g):
    xf = x.astype(jnp.float32)
    y = xf * lax.rsqrt(jnp.mean(xf * xf, axis=-1, keepdims=True) + RMS_EPS)
    return (y * g.astype(jnp.float32)).astype(x.dtype)


def _swiglu(h, w_in, w_out):
    gate, up = jnp.split(h @ w_in, 2, axis=-1)
    return (jax.nn.silu(gate) * up) @ w_out


def _rope(t, seq_len):
    d = t.shape[-1]
    inv_freq = ROPE_THETA ** (-jnp.arange(0, d, 2, dtype=jnp.float32) / d)
    ang = jnp.arange(seq_len, dtype=jnp.float32)[:, None] * inv_freq[None, :]
    cos, sin = jnp.cos(ang), jnp.sin(ang)
    t1, t2 = t[..., : d // 2], t[..., d // 2:]
    return jnp.concatenate([t1 * cos - t2 * sin, t2 * cos + t1 * sin], axis=-1)


def _diff_attention(q, k, v, lam_vecs, subln_g, lam_init):
    B, S, _ = q.shape
    q = q.reshape(B, S, DA_HEADS, 2, DA_HEAD_DIM).transpose(0, 2, 3, 1, 4)
    k = k.reshape(B, S, DA_HEADS, 2, DA_HEAD_DIM).transpose(0, 2, 3, 1, 4)
    v = v.reshape(B, S, DA_HEADS, DA_V_DIM).transpose(0, 2, 1, 3)
    q = _rope(q, S) * (DA_HEAD_DIM ** -0.5)
    k = _rope(k, S)
    lam = (jnp.exp(jnp.sum(lam_vecs[0] * lam_vecs[1]))
           - jnp.exp(jnp.sum(lam_vecs[2] * lam_vecs[3])) + lam_init)
    n_blk = S // Q_BLOCK
    q_blocks = q.reshape(B, DA_HEADS, 2, n_blk, Q_BLOCK, DA_HEAD_DIM).transpose(3, 0, 1, 2, 4, 5)
    key_chunk = jnp.arange(S) // CHUNK

    def block(args):
        q_blk, blk = args
        s = jnp.einsum('bhcqd,bhckd->bhcqk', q_blk, k)
        q_chunk = (blk * Q_BLOCK + jnp.arange(Q_BLOCK)) // CHUNK
        mask = key_chunk[None, :] <= q_chunk[:, None]
        p = jax.nn.softmax(jnp.where(mask, s, -jnp.inf), axis=-1)
        a = p[:, :, 0] - lam * p[:, :, 1]
        return jnp.einsum('bhqk,bhkd->bhqd', a, v)

    o = lax.map(block, (q_blocks, jnp.arange(n_blk)))
    o = o.transpose(1, 0, 3, 2, 4).reshape(B, S, DA_HEADS, DA_V_DIM)
    o = _rmsnorm(o, subln_g) * (1.0 - lam_init)
    return o.reshape(B, S, DA_WIDTH)


def _causal_conv(t, w, b):
    S = t.shape[1]
    tp = jnp.pad(t, ((0, 0), (ML_CONV - 1, 0), (0, 0)))
    y = b
    for j in range(ML_CONV):
        y = y + w[j] * tp[:, j:j + S]
    return y


def _mlstm(qk, v, o, gates, conv_w, conv_b, gate_b, norm_g):
    B, S, _ = v.shape
    NC = S // CHUNK
    qk = jax.nn.silu(_causal_conv(qk, conv_w, conv_b))
    q, k = jnp.split(qk, 2, axis=-1)

    def chunks(t, d):
        return t.reshape(B, NC, CHUNK, ML_HEADS, d).transpose(0, 3, 1, 2, 4)

    q = chunks(q, ML_QK_DIM) * (ML_QK_DIM ** -0.5)
    k = chunks(k, ML_QK_DIM)
    v = chunks(v, ML_V_DIM)
    g = (gates + gate_b).reshape(B, NC, CHUNK, 2, ML_HEADS).transpose(3, 0, 4, 1, 2)
    log_i = g[0]
    log_f = jax.nn.log_sigmoid(g[1])
    b = jnp.cumsum(log_f, axis=-1)
    b_last = b[..., -1]
    a = b_last[..., None] - b + log_i

    def step(carry, xs):
        C, n, m = carry
        k_c, v_c, a_c, bl = xs
        m_new = jnp.maximum(bl + m, a_c.max(-1))
        w = jnp.exp(a_c - m_new[..., None])
        decay = jnp.exp(bl + m - m_new)
        C_new = decay[..., None, None] * C + jnp.einsum('bhl,bhle,bhld->bhed', w, v_c, k_c)
        n_new = decay[..., None] * n + jnp.einsum('bhl,bhld->bhd', w, k_c)
        return (C_new, n_new, m_new), (C, n, m)

    init = (jnp.zeros((B, ML_HEADS, ML_V_DIM, ML_QK_DIM), jnp.float32),
            jnp.zeros((B, ML_HEADS, ML_QK_DIM), jnp.float32),
            jnp.zeros((B, ML_HEADS), jnp.float32))
    xs = (k.transpose(2, 0, 1, 3, 4), v.transpose(2, 0, 1, 3, 4),
          a.transpose(2, 0, 1, 3), b_last.transpose(2, 0, 1))
    _, (C_prev, n_prev, m_prev) = lax.scan(step, init, xs)
    C_prev = C_prev.transpose(1, 2, 0, 3, 4)
    n_prev = n_prev.transpose(1, 2, 0, 3)
    m_prev = m_prev.transpose(1, 2, 0)

    causal = jnp.tril(jnp.ones((CHUNK, CHUNK), dtype=bool))
    D = jnp.where(causal, b[..., :, None] - b[..., None, :] + log_i[..., None, :], -jnp.inf)
    m_inter = b + m_prev[..., None]
    m = jnp.maximum(m_inter, D.max(-1))
    w = jnp.exp(D - m[..., None]) * jnp.einsum('bhcjd,bhcsd->bhcjs', q, k)
    decay = jnp.exp(m_inter - m)
    num = (jnp.einsum('bhcjs,bhcse->bhcje', w, v)
           + decay[..., None] * jnp.einsum('bhcjd,bhced->bhcje', q, C_prev))
    den = w.sum(-1) + decay * jnp.einsum('bhcjd,bhcd->bhcj', q, n_prev)
    h = num / jnp.maximum(jnp.abs(den), jnp.exp(-m))[..., None]
    h = h.transpose(0, 2, 3, 1, 4).reshape(B, S, ML_HEADS, ML_V_DIM)
    h = _rmsnorm(h, norm_g).reshape(B, S, ML_WIDTH)
    return jax.nn.sigmoid(o) * h


def _mixer(h, w_in, w_out, lam_vecs, subln_g, lam_init, conv_w, conv_b, gate_b, ml_norm_g):
    proj = (h @ w_in).astype(jnp.float32)
    da_q, da_k, da_v, ml_qk, ml_v, ml_o, ml_g = jnp.split(proj, SPLIT_IDX, axis=-1)
    y_da = _diff_attention(da_q, da_k, da_v, lam_vecs, subln_g, lam_init)
    y_ml = _mlstm(ml_qk, ml_v, ml_o, ml_g, conv_w, conv_b, gate_b, ml_norm_g)
    y = jnp.concatenate([y_da, y_ml], axis=-1).astype(h.dtype)
    return y @ w_out


def setup_inputs(seed: int = 0) -> dict:
    key = jax.random.key(seed)
    ks = jax.random.split(key, 13)
    f32 = jnp.float32
    x = jax.random.normal(ks[0], (BATCH, SEQ, D_MODEL), f32)
    ffn_w_in = jax.random.normal(ks[1], (DEPTH, 2, D_MODEL, 2 * D_FF), f32) * D_MODEL ** -0.5
    ffn_w_out = jax.random.normal(ks[2], (DEPTH, 2, D_FF, D_MODEL), f32) * D_FF ** -0.5
    norm_gains = 1.0 + 0.05 * jax.random.normal(ks[3], (DEPTH, 6, D_MODEL), f32)
    mix_w_in = jax.random.normal(ks[4], (DEPTH, D_MODEL, IN_COLS), f32) * D_MODEL ** -0.5
    mix_w_out = jax.random.normal(ks[5], (DEPTH, MIX_WIDTH, D_MODEL), f32) * MIX_WIDTH ** -0.5
    da_lambda = 0.1 * jax.random.normal(ks[6], (DEPTH, 4, DA_HEAD_DIM), f32)
    da_subln_g = 1.0 + 0.05 * jax.random.normal(ks[7], (DEPTH, DA_V_DIM), f32)
    ml_conv_w = jax.random.normal(ks[8], (DEPTH, ML_CONV, ML_QK_COLS), f32) * ML_CONV ** -0.5
    ml_conv_b = 0.01 * jax.random.normal(ks[9], (DEPTH, ML_QK_COLS), f32)
    ml_gate_b = jnp.concatenate([
        0.1 * jax.random.normal(ks[10], (DEPTH, ML_HEADS), f32),
        jax.random.uniform(ks[11], (DEPTH, ML_HEADS), f32, minval=3.0, maxval=6.0)], axis=-1)
    ml_norm_g = 1.0 + 0.05 * jax.random.normal(ks[12], (DEPTH, ML_V_DIM), f32)
    return {'x': x, 'ffn_w_in': ffn_w_in, 'ffn_w_out': ffn_w_out, 'norm_gains': norm_gains,
            'mix_w_in': mix_w_in, 'mix_w_out': mix_w_out, 'da_lambda': da_lambda,
            'da_subln_g': da_subln_g, 'ml_conv_w': ml_conv_w, 'ml_conv_b': ml_conv_b,
            'ml_gate_b': ml_gate_b, 'ml_norm_g': ml_norm_g}


def reference(x, ffn_w_in, ffn_w_out, norm_gains, mix_w_in, mix_w_out, da_lambda,
              da_subln_g, ml_conv_w, ml_conv_b, ml_gate_b, ml_norm_g):
    for l in range(DEPTH):
        g = norm_gains[l]
        h = _swiglu(_rmsnorm(x, g[0]), ffn_w_in[l, 0], ffn_w_out[l, 0])
        x = x + 0.5 * _rmsnorm(h, g[1])
        lam_init = 0.8 - 0.6 * math.exp(-0.3 * l)
        h = _mixer(_rmsnorm(x, g[2]), mix_w_in[l], mix_w_out[l], da_lambda[l], da_subln_g[l],
                   lam_init, ml_conv_w[l], ml_conv_b[l], ml_gate_b[l], ml_norm_g[l])
        x = x + _rmsnorm(h, g[3])
        h = _swiglu(_rmsnorm(x, g[4]), ffn_w_in[l, 1], ffn_w_out[l, 1])
        x = x + 0.5 * _rmsnorm(h, g[5])
    return x
```

```cpp
#include <hip/hip_runtime.h>
#include <hip/hip_cooperative_groups.h>
#include <cstdio>
#include <cstdint>
namespace cg = cooperative_groups;

#ifndef ONE_LAUNCH
#define ONE_LAUNCH 1
#endif

#ifndef D_PRO
#define D_PRO 1
#endif
#ifndef D_G1
#define D_G1 1
#endif
#ifndef D_G2
#define D_G2 1
#endif
#ifndef D_G3
#define D_G3 1
#endif
#ifndef D_M1
#define D_M1 1
#endif
#ifndef D_M2
#define D_M2 1
#endif
#ifndef D_AT
#define D_AT 1
#endif
#ifndef D_M3
#define D_M3 1
#endif
#ifndef PROBE_MASK
#define PROBE_MASK 0
#endif
#ifndef EN_ALL
#define EN_ALL 1
#endif
#ifndef EN_PRO
#define EN_PRO EN_ALL
#endif
#ifndef EN_G1
#define EN_G1 EN_ALL
#endif
#ifndef EN_G2
#define EN_G2 EN_ALL
#endif
#ifndef EN_N
#define EN_N EN_ALL
#endif
#ifndef EN_G3A
#define EN_G3A EN_ALL
#endif
#ifndef EN_G3B
#define EN_G3B EN_ALL
#endif
#ifndef EN_M1
#define EN_M1 EN_ALL
#endif
#ifndef EN_M2
#define EN_M2 EN_ALL
#endif
#ifndef EN_AT
#define EN_AT EN_ALL
#endif
#ifndef EN_M3
#define EN_M3 EN_ALL
#endif
#define LAS __attribute__((address_space(3)))
#define DI __device__ __forceinline__
typedef unsigned short bf16_t;
typedef short bf16x8 __attribute__((ext_vector_type(8)));
typedef float f32x4 __attribute__((ext_vector_type(4)));
typedef float f32x16 __attribute__((ext_vector_type(16)));
typedef unsigned u32x4 __attribute__((ext_vector_type(4)));
typedef unsigned u32x2 __attribute__((ext_vector_type(2)));
typedef __bf16 bf16x2_t __attribute__((ext_vector_type(2)));
typedef float f32x2_t __attribute__((ext_vector_type(2)));

constexpr int NB = 2, SEQ = 8192, M = NB * SEQ, D = 1024, DFF = 2816, NL = 2;
constexpr int MIXN = 3080;
constexpr float EPS = 1e-6f;
constexpr float LOG2E = 1.4426950408889634f;
constexpr float QSCALE = 0.125f * LOG2E;

constexpr size_t MiB = 1u << 20;
constexpr size_t WS_WIN = 0;
constexpr size_t WS_WOUT = 44 * MiB;
constexpr size_t WS_WMIXIN = 66 * MiB;
constexpr size_t WS_WMIXOUT = 78 * MiB;
constexpr size_t WS_GATES = 84 * MiB;
constexpr size_t WS_BCUM = WS_GATES + 512 * 1024;
constexpr size_t WS_LOGI = WS_BCUM + 256 * 1024;
constexpr size_t WS_NHAT = WS_LOGI + 256 * 1024;
constexpr size_t WS_NPREV = WS_NHAT + 256 * 1024;
constexpr size_t WS_CHS = WS_NPREV + 256 * 1024;
constexpr size_t WS_BAR = WS_CHS + 64 * 1024;
constexpr size_t WS_XN = 86 * MiB;
constexpr size_t WS_A = 118 * MiB;
constexpr size_t WS_Q = WS_A, WS_K = WS_A + 16 * MiB, WS_VTDA = WS_A + 32 * MiB, WS_VTML = WS_A + 48 * MiB, WS_MLO = WS_A + 64 * MiB, WS_QC = WS_A + 80 * MiB, WS_KC = WS_A + 88 * MiB;
constexpr size_t WS_Y = 214 * MiB;
constexpr size_t WS_MLQK = WS_Y, WS_CPREV = WS_Y, WS_UHAT = WS_Y + 32 * MiB;
constexpr size_t WS_END = 278 * MiB;

constexpr int LDS_BYTES = 147456;
constexpr int NTHREADS = 512;

DI unsigned pk2(float lo, float hi) { f32x2_t v = {lo, hi}; bf16x2_t b = __builtin_convertvector(v, bf16x2_t); return __builtin_bit_cast(unsigned, b); }
DI float bf_lo(unsigned u) { return __builtin_bit_cast(float, u << 16); }
DI float bf_hi(unsigned u) { return __builtin_bit_cast(float, u & 0xffff0000u); }
DI float dpp_f(float v, const int ctrl_sel) {
    const int x = __builtin_bit_cast(int, v);
    int r;
    if (ctrl_sel == 0) r = __builtin_amdgcn_update_dpp(0, x, 0xB1, 0xF, 0xF, true);
    else if (ctrl_sel == 1) r = __builtin_amdgcn_update_dpp(0, x, 0x4E, 0xF, 0xF, true);
    else if (ctrl_sel == 2) r = __builtin_amdgcn_update_dpp(0, x, 0x141, 0xF, 0xF, true);
    else r = __builtin_amdgcn_update_dpp(0, x, 0x140, 0xF, 0xF, true);
    return __builtin_bit_cast(float, r);
}
DI float wave_sum_dpp(float v) {
    v += dpp_f(v, 0); v += dpp_f(v, 1); v += dpp_f(v, 2); v += dpp_f(v, 3);
    { auto rr = __builtin_amdgcn_permlane16_swap(__builtin_bit_cast(unsigned, v), __builtin_bit_cast(unsigned, v), false, false);
      v = __builtin_bit_cast(float, (unsigned)rr[0]) + __builtin_bit_cast(float, (unsigned)rr[1]); }
    { auto rr = __builtin_amdgcn_permlane32_swap(__builtin_bit_cast(unsigned, v), __builtin_bit_cast(unsigned, v), false, false);
      v = __builtin_bit_cast(float, (unsigned)rr[0]) + __builtin_bit_cast(float, (unsigned)rr[1]); }
    return v;
}
DI float wave_max_dpp(float v) {
    v = fmaxf(v, dpp_f(v, 0)); v = fmaxf(v, dpp_f(v, 1)); v = fmaxf(v, dpp_f(v, 2)); v = fmaxf(v, dpp_f(v, 3));
    { auto rr = __builtin_amdgcn_permlane16_swap(__builtin_bit_cast(unsigned, v), __builtin_bit_cast(unsigned, v), false, false);
      v = fmaxf(__builtin_bit_cast(float, (unsigned)rr[0]), __builtin_bit_cast(float, (unsigned)rr[1])); }
    { auto rr = __builtin_amdgcn_permlane32_swap(__builtin_bit_cast(unsigned, v), __builtin_bit_cast(unsigned, v), false, false);
      v = fmaxf(__builtin_bit_cast(float, (unsigned)rr[0]), __builtin_bit_cast(float, (unsigned)rr[1])); }
    return v;
}
DI float half_sum(float v) { auto rr = __builtin_amdgcn_permlane32_swap(__builtin_bit_cast(unsigned, v), __builtin_bit_cast(unsigned, v), false, false);
    return __builtin_bit_cast(float, (unsigned)rr[0]) + __builtin_bit_cast(float, (unsigned)rr[1]); }
DI float half_max(float v) { auto rr = __builtin_amdgcn_permlane32_swap(__builtin_bit_cast(unsigned, v), __builtin_bit_cast(unsigned, v), false, false);
    return fmaxf(__builtin_bit_cast(float, (unsigned)rr[0]), __builtin_bit_cast(float, (unsigned)rr[1])); }
DI float shfl_from(float v, int src_lane) { return __builtin_bit_cast(float, __builtin_amdgcn_ds_bpermute(src_lane << 2, __builtin_bit_cast(int, v))); }
DI int crow(int reg, int h) { return (reg & 3) + 8 * (reg >> 2) + 4 * h; }
DI float max3f(float a, float b, float c) { float r; asm("v_max3_f32 %0, %1, %2, %3" : "=v"(r) : "v"(a), "v"(b), "v"(c)); return r; }
#define MFMA32(a, b, c) __builtin_amdgcn_mfma_f32_32x32x16_bf16((a), (b), (c), 0, 0, 0)

namespace pg8 {
constexpr int BM = 256, BK = 64, HALF = 128, HTB = HALF * BK * 2, STAGE_BYTES = 8 * HTB, NXCD = 8, WGM = 8;
DI int lds_byte(int r, int c) { const int st = (r >> 4) * 2 + (c >> 5), rr = r & 15, cc = c & 31, ob = rr * 64 + cc * 2; return st * 1024 + (ob ^ (((ob >> 9) & 1) << 5)); }
DI void stage_rc(int b, int& R, int& C) { const int st = b / 1024, sb = b % 1024, swz = sb ^ (((sb >> 9) & 1) << 5); R = (st >> 1) * 16 + swz / 64; C = (st & 1) * 32 + (swz % 64) / 2; }
DI int perm32(int rho) { const int n = rho >> 4, i = rho & 15; return 8 * (i >> 2) + 4 * n + (i & 3); }
struct Unit { int pm, pn; };
struct Gemm { const bf16_t* A; const bf16_t* Bt; int M, N, K; };
struct StaticOrder {
    int nM, nN, nwg, G, c;
    DI void init(int M_, int N_, int G_, int c_) { nM = M_ / BM; nN = N_ / BM; nwg = nM * nN; G = G_; c = c_; }
    DI bool next(int i, Unit& u) const {
        const long L = (long)i * G + c; if (L >= nwg) return false;
        int wgid = (int)L; { const int q = nwg / NXCD, r = nwg % NXCD, xcd = wgid % NXCD, off = wgid / NXCD; wgid = (xcd < r ? xcd * (q + 1) : r * (q + 1) + (xcd - r) * q) + off; }
        const int nig = WGM * nN, gid = wgid / nig, fm = gid * WGM, gsz = (nM - fm) < WGM ? (nM - fm) : WGM;
        u.pm = fm + ((wgid % nig) % gsz); u.pn = (wgid % nig) / gsz; return true;
    }
};

template <class Epi>
DI void gemm_phase(LAS unsigned char* lds, const int tid, const Gemm g, const StaticOrder& S, const Epi& E) {
    const int wid = __builtin_amdgcn_readfirstlane(tid >> 6), lane = tid & 63, wr = wid >> 2, wc = wid & 3, fr = lane & 15, fq = lane >> 4;
    const int K = g.K, nt = K / BK;
    unsigned voffA[2], voffB[2];
#pragma unroll
    for (int i = 0; i < 2; ++i) { int R, C; stage_rc(tid * 16 + i * 8192, R, C); const int Rb = Epi::PERM ? ((R & ~31) + perm32(R & 31)) : R;
        voffA[i] = (unsigned)(R * K + C) * 2u; voffB[i] = (unsigned)(Rb * K + C) * 2u; }
    const size_t kstep = (size_t)(BK * 2);
    const size_t hstep = (size_t)HALF * K * 2;
    const size_t tstep = 2 * hstep;
    const unsigned ldsw = (unsigned)wid * 1024u;
    const int aoff = lds_byte(wr * 64 + fr, fq * 8), boff = lds_byte(wc * 32 + fr, fq * 8);
#define PG8_SA(b, h) (((b) * 2 + (h)) * HTB)
#define PG8_SB(b, h) ((4 + (b) * 2 + (h)) * HTB)
#define PG8_STAGE(bufoff, gbase, voff) do { _Pragma("unroll") for (int _i = 0; _i < 2; ++_i) \
        __builtin_amdgcn_global_load_lds((const unsigned*)((const char*)(gbase) + (voff)[_i]), (LAS unsigned*)(lds + (bufoff) + ldsw + _i * 8192), 16, 0, 0); } while (0)
#define PG8_LDA(dst, b, h) do { _Pragma("unroll") for (int m = 0; m < 4; ++m) _Pragma("unroll") for (int k = 0; k < 2; ++k) dst[m][k] = *(const LAS bf16x8*)(lds + PG8_SA(b, h) + aoff + m * 2048 + k * 1024); } while (0)
#define PG8_LDB(dst, b, h) do { _Pragma("unroll") for (int n = 0; n < 2; ++n) _Pragma("unroll") for (int k = 0; k < 2; ++k) dst[n][k] = *(const LAS bf16x8*)(lds + PG8_SB(b, h) + boff + n * 2048 + k * 1024); } while (0)
#define PG8_MMA(ai, bj, At, Bt) do { __builtin_amdgcn_s_setprio(1); _Pragma("unroll") for (int m = 0; m < 4; ++m) _Pragma("unroll") for (int n = 0; n < 2; ++n) _Pragma("unroll") for (int k = 0; k < 2; ++k) \
        acc[ai][bj][m][n] = Epi::TRANS ? __builtin_amdgcn_mfma_f32_16x16x32_bf16(Bt[n][k], At[m][k], acc[ai][bj][m][n], 0, 0, 0) \
                                       : __builtin_amdgcn_mfma_f32_16x16x32_bf16(At[m][k], Bt[n][k], acc[ai][bj][m][n], 0, 0, 0); __builtin_amdgcn_s_setprio(0); } while (0)
#define PG8_WAIT_V(n) asm volatile("s_waitcnt vmcnt(" #n ")" ::: "memory")
#define PG8_WAIT_L(n) asm volatile("s_waitcnt lgkmcnt(" #n ")" ::: "memory")
#define PG8_BAR __builtin_amdgcn_s_barrier()
#define PG8_SCHED __builtin_amdgcn_sched_barrier(0)
    Unit cur, nxt; int ui = 0;
    if (!S.next(0, cur)) return;
    f32x4 acc[2][2][4][2];
#pragma unroll
    for (int a = 0; a < 2; ++a)
#pragma unroll
        for (int b = 0; b < 2; ++b)
#pragma unroll
            for (int m = 0; m < 4; ++m)
#pragma unroll
                for (int n = 0; n < 2; ++n) acc[a][b][m][n] = (f32x4){0.f, 0.f, 0.f, 0.f};
    bf16x8 At[4][2], B0[2][2], B1[2][2];
    const char* cA = (const char*)g.A + (size_t)cur.pm * tstep; const char* cB = (const char*)g.Bt + (size_t)cur.pn * tstep;
    PG8_STAGE(PG8_SB(0, 0), cB, voffB); PG8_STAGE(PG8_SB(0, 1), cB + hstep, voffB); PG8_STAGE(PG8_SA(0, 0), cA, voffA); PG8_STAGE(PG8_SA(0, 1), cA + hstep, voffA);
    if (wr == 1) PG8_BAR;
    PG8_WAIT_V(2); PG8_BAR;
    PG8_STAGE(PG8_SB(1, 0), cB + kstep, voffB); PG8_STAGE(PG8_SA(1, 0), cA + kstep, voffA); PG8_STAGE(PG8_SB(1, 1), cB + hstep + kstep, voffB);
    PG8_WAIT_V(6); PG8_BAR;
    for (;;) {
        const bool has_next = S.next(ui + 1, nxt);
        const char* nA = has_next ? (const char*)g.A + (size_t)nxt.pm * tstep : cA; const char* nB = has_next ? (const char*)g.Bt + (size_t)nxt.pn * tstep : cB;
        for (int t = 0; t < nt; t += 2) {
            const bool last = (t == nt - 2);
            const char* a1 = cA + (size_t)(t + 1) * kstep;
            const char* a2 = last ? nA : cA + (size_t)(t + 2) * kstep; const char* b2 = last ? nB : cB + (size_t)(t + 2) * kstep;
            const char* a3 = a2 + kstep; const char* b3 = b2 + kstep;
            PG8_LDB(B0, 0, 0); PG8_LDB(B1, 0, 1); PG8_SCHED; PG8_LDA(At, 0, 0); PG8_STAGE(PG8_SA(1, 1), a1 + hstep, voffA);
            PG8_WAIT_V(8); PG8_WAIT_L(0); PG8_BAR; PG8_MMA(0, 0, At, B0); PG8_MMA(0, 1, At, B1); PG8_BAR; PG8_SCHED;
            PG8_LDA(At, 0, 1); PG8_STAGE(PG8_SB(0, 0), b2, voffB); PG8_STAGE(PG8_SB(0, 1), b2 + hstep, voffB); PG8_STAGE(PG8_SA(0, 0), a2, voffA);
            PG8_WAIT_V(8); PG8_WAIT_L(0); PG8_BAR; PG8_MMA(1, 0, At, B0); PG8_MMA(1, 1, At, B1); PG8_BAR; PG8_SCHED;
            PG8_LDB(B0, 1, 0); PG8_LDB(B1, 1, 1); PG8_SCHED; PG8_LDA(At, 1, 0); PG8_STAGE(PG8_SA(0, 1), a2 + hstep, voffA);
            PG8_WAIT_V(8); PG8_WAIT_L(0); PG8_BAR; PG8_MMA(0, 0, At, B0); PG8_MMA(0, 1, At, B1); PG8_BAR; PG8_SCHED;
            PG8_LDA(At, 1, 1); PG8_STAGE(PG8_SB(1, 0), b3, voffB); PG8_STAGE(PG8_SB(1, 1), b3 + hstep, voffB); PG8_STAGE(PG8_SA(1, 0), a3, voffA);
            PG8_WAIT_V(8); PG8_WAIT_L(0); PG8_BAR; PG8_MMA(1, 0, At, B0); PG8_MMA(1, 1, At, B1); PG8_BAR; PG8_SCHED;
        }
        if (wr == 0) PG8_BAR;
        E(acc, cur, wr, wc, fr, fq);
        if (!has_next) break;
#pragma unroll
        for (int a = 0; a < 2; ++a)
#pragma unroll
            for (int b = 0; b < 2; ++b)
#pragma unroll
                for (int m = 0; m < 4; ++m)
#pragma unroll
                    for (int n = 0; n < 2; ++n) acc[a][b][m][n] = (f32x4){0.f, 0.f, 0.f, 0.f};
        cur = nxt; cA = nA; cB = nB; ++ui;
        if (wr == 1) PG8_BAR;
    }
    PG8_WAIT_V(0);
    PG8_BAR;
#undef PG8_SA
#undef PG8_SB
#undef PG8_STAGE
#undef PG8_LDA
#undef PG8_LDB
#undef PG8_MMA
#undef PG8_WAIT_V
#undef PG8_WAIT_L
#undef PG8_BAR
#undef PG8_SCHED
}

DI float silu_mul(float g, float u) { return g * __builtin_amdgcn_rcpf(1.f + __builtin_amdgcn_exp2f(-g * LOG2E)) * u; }

struct EpiSwiglu {
    static constexpr bool PERM = true, TRANS = true;
    bf16_t* O;
    DI void operator()(const f32x4 (&acc)[2][2][4][2], const Unit& u, int wr, int wc, int fr, int fq) const {
        const int row0 = u.pm * BM + wr * 64 + fr, col0 = u.pn * 128 + wc * 32 + 8 * fq;
#pragma unroll
        for (int ai = 0; ai < 2; ++ai)
#pragma unroll
            for (int m = 0; m < 4; ++m) {
                const f32x4 g0 = acc[ai][0][m][0], g1 = acc[ai][0][m][1], u0 = acc[ai][1][m][0], u1 = acc[ai][1][m][1];
                u32x4 w;
                w.x = pk2(silu_mul(g0[0], u0[0]), silu_mul(g0[1], u0[1])); w.y = pk2(silu_mul(g0[2], u0[2]), silu_mul(g0[3], u0[3]));
                w.z = pk2(silu_mul(g1[0], u1[0]), silu_mul(g1[1], u1[1])); w.w = pk2(silu_mul(g1[2], u1[2]), silu_mul(g1[3], u1[3]));
                *(u32x4*)(O + (size_t)(row0 + ai * HALF + m * 16) * DFF + col0) = w;
            }
    }
};

struct EpiBf16 {
    static constexpr bool PERM = true, TRANS = true;
    bf16_t* O; int ldc;
    DI void operator()(const f32x4 (&acc)[2][2][4][2], const Unit& u, int wr, int wc, int fr, int fq) const {
        const int row0 = u.pm * BM + wr * 64 + fr, col0 = u.pn * BM + wc * 32 + 8 * fq;
#pragma unroll
        for (int ai = 0; ai < 2; ++ai)
#pragma unroll
            for (int m = 0; m < 4; ++m) {
                bf16_t* rowp = O + (size_t)(row0 + ai * HALF + m * 16) * ldc + col0;
#pragma unroll
                for (int bj = 0; bj < 2; ++bj) { const f32x4 v0 = acc[ai][bj][m][0], v1 = acc[ai][bj][m][1];
                    u32x4 w; w.x = pk2(v0[0], v0[1]); w.y = pk2(v0[2], v0[3]); w.z = pk2(v1[0], v1[1]); w.w = pk2(v1[2], v1[3]);
                    *(u32x4*)(rowp + bj * HALF) = w; }
            }
    }
};

struct EpiMix {
    static constexpr bool PERM = true, TRANS = true;
    bf16_t* Q; bf16_t* Kd; float* MLQK; bf16_t* MLO;
    DI void operator()(const f32x4 (&acc)[2][2][4][2], const Unit& u, int wr, int wc, int fr, int fq) const {
        const int row0 = u.pm * BM + wr * 64 + fr; const int pn = u.pn;
        if (pn < 4) {
            bf16_t* dst = (pn < 2) ? Q : Kd; const float sc = (pn < 2) ? QSCALE : 1.f;
            const int G = (pn & 1) * 4 + wc, head = G >> 1, c = G & 1;
            float ifr[8];
#pragma unroll
            for (int j = 0; j < 8; ++j) ifr[j] = __builtin_amdgcn_exp2f(-(float)(2 * (8 * fq + j)) * (13.287712379549449f / 64.f));
#pragma unroll
            for (int ai = 0; ai < 2; ++ai)
#pragma unroll
                for (int m = 0; m < 4; ++m) {
                    const int row = row0 + ai * HALF + m * 16, b = row >> 13, s = row & (SEQ - 1);
                    const float sf = (float)s;
                    float cs[8], sn[8];
#pragma unroll
                    for (int j = 0; j < 8; ++j) { float rev = (sf * ifr[j]) * 0.15915494309189535f; rev = __builtin_amdgcn_fractf(rev); cs[j] = __builtin_amdgcn_cosf(rev); sn[j] = __builtin_amdgcn_sinf(rev); }
                    const f32x4 r0 = {cs[0], sn[0], cs[1], sn[1]}, r1 = {cs[2], sn[2], cs[3], sn[3]}, r2 = {cs[4], sn[4], cs[5], sn[5]}, r3 = {cs[6], sn[6], cs[7], sn[7]};
                    const f32x4 a0 = acc[ai][0][m][0], a1 = acc[ai][0][m][1], b0 = acc[ai][1][m][0], b1 = acc[ai][1][m][1];
                    u32x4 w1, w2;
                    w1.x = pk2((a0[0] * r0[0] - b0[0] * r0[1]) * sc, (a0[1] * r0[2] - b0[1] * r0[3]) * sc);
                    w1.y = pk2((a0[2] * r1[0] - b0[2] * r1[1]) * sc, (a0[3] * r1[2] - b0[3] * r1[3]) * sc);
                    w1.z = pk2((a1[0] * r2[0] - b1[0] * r2[1]) * sc, (a1[1] * r2[2] - b1[1] * r2[3]) * sc);
                    w1.w = pk2((a1[2] * r3[0] - b1[2] * r3[1]) * sc, (a1[3] * r3[2] - b1[3] * r3[3]) * sc);
                    w2.x = pk2((b0[0] * r0[0] + a0[0] * r0[1]) * sc, (b0[1] * r0[2] + a0[1] * r0[3]) * sc);
                    w2.y = pk2((b0[2] * r1[0] + a0[2] * r1[1]) * sc, (b0[3] * r1[2] + a0[3] * r1[3]) * sc);
                    w2.z = pk2((b1[0] * r2[0] + a1[0] * r2[1]) * sc, (b1[1] * r2[2] + a1[1] * r2[3]) * sc);
                    w2.w = pk2((b1[2] * r3[0] + a1[2] * r3[1]) * sc, (b1[3] * r3[2] + a1[3] * r3[3]) * sc);
                    bf16_t* base = dst + ((size_t)(((b * 4 + head) * 2 + c) * SEQ + s)) * 64 + 8 * fq;
                    *(u32x4*)base = w1; *(u32x4*)(base + 32) = w2;
                }
        } else if (pn < 6) {
            const int col0 = (pn - 4) * BM + wc * 32 + 8 * fq;
#pragma unroll
            for (int ai = 0; ai < 2; ++ai)
#pragma unroll
                for (int m = 0; m < 4; ++m) {
                    float* rowp = MLQK + (size_t)(row0 + ai * HALF + m * 16) * 512 + col0;
#pragma unroll
                    for (int bj = 0; bj < 2; ++bj) { *(f32x4*)(rowp + bj * HALF) = acc[ai][bj][m][0]; *(f32x4*)(rowp + bj * HALF + 4) = acc[ai][bj][m][1]; }
                }
        } else {
            const int col0 = (pn - 6) * BM + wc * 32 + 8 * fq;
#pragma unroll
            for (int ai = 0; ai < 2; ++ai)
#pragma unroll
                for (int m = 0; m < 4; ++m) {
                    bf16_t* rowp = MLO + (size_t)(row0 + ai * HALF + m * 16) * 512 + col0;
#pragma unroll
                    for (int bj = 0; bj < 2; ++bj) { const f32x4 v0 = acc[ai][bj][m][0], v1 = acc[ai][bj][m][1];
                        u32x4 w; w.x = pk2(v0[0], v0[1]); w.y = pk2(v0[2], v0[3]); w.z = pk2(v1[0], v1[1]); w.w = pk2(v1[2], v1[3]);
                        *(u32x4*)(rowp + bj * HALF) = w; }
                }
        }
    }
};

struct EpiVT {
    static constexpr bool PERM = false, TRANS = false;
    bf16_t* VTda; bf16_t* VTml;
    DI void operator()(const f32x4 (&acc)[2][2][4][2], const Unit& u, int wr, int wc, int fr, int fq) const {
        bf16_t* dst = (u.pn < 2) ? VTda : VTml;
#pragma unroll
        for (int ai = 0; ai < 2; ++ai)
#pragma unroll
            for (int m = 0; m < 4; ++m) {
                const int row = u.pm * BM + ai * HALF + wr * 64 + m * 16 + 4 * fq, b = row >> 13, s = row & (SEQ - 1);
#pragma unroll
                for (int bj = 0; bj < 2; ++bj)
#pragma unroll
                    for (int n = 0; n < 2; ++n) {
                        const int head = (u.pn & 1) * 2 + bj, d = wc * 32 + n * 16 + fr;
                        const f32x4 v = acc[ai][bj][m][n];
                        u32x2 w; w.x = pk2(v[0], v[1]); w.y = pk2(v[2], v[3]);
                        *(u32x2*)(dst + ((size_t)((b * 4 + head) * 128 + d)) * SEQ + s) = w;
                    }
            }
    }
};
}

struct Args { const float* in[12]; float* out; unsigned char* ws; int ph_lo, ph_hi; };

struct Ctx {
    LAS unsigned char* lds;
    int tid, lane, wave, bid, G;
    const float *x, *ffn_w_in, *ffn_w_out, *norm_g, *mix_w_in, *mix_w_out, *da_lambda, *da_subln_g, *conv_w, *conv_b, *gate_b, *ml_norm_g;
    float* out; unsigned char* ws;
};

DI void transpose_item(const float* W, int N, int K, int k0, int src_n0, bf16_t* WT, int dst_row0, LAS float* scr, int lane) {
    const int kr = lane >> 3, n4 = (lane & 7) * 4;
    f32x4 v[8];
#pragma unroll
    for (int i = 0; i < 8; ++i) v[i] = *(const f32x4*)(W + (size_t)(k0 + kr + 8 * i) * N + src_n0 + n4);
#pragma unroll
    for (int i = 0; i < 8; ++i) { LAS float* p = scr + (kr + 8 * i) * 33 + n4; p[0] = v[i][0]; p[1] = v[i][1]; p[2] = v[i][2]; p[3] = v[i][3]; }
    asm volatile("s_waitcnt lgkmcnt(0)" ::: "memory");
    const int c = lane & 7;
#pragma unroll
    for (int j = 0; j < 4; ++j) { const int n = (lane >> 3) + 8 * j; const LAS float* s = scr + (8 * c) * 33 + n;
        u32x4 o; o.x = pk2(s[0 * 33], s[1 * 33]); o.y = pk2(s[2 * 33], s[3 * 33]); o.z = pk2(s[4 * 33], s[5 * 33]); o.w = pk2(s[6 * 33], s[7 * 33]);
        *(u32x4*)(WT + (size_t)(dst_row0 + n) * K + k0 + 8 * c) = o; }
    asm volatile("s_waitcnt lgkmcnt(0)" ::: "memory");
}

DI void norm_phase(const Ctx& F, const float* xsrc, float* xdst, const bf16_t* Y, const float* gpost, float coef, const float* gpre, bf16_t* XN,
                   const float* Wg, const float* gate_b, float* gates) {
    LAS float* wgT = (LAS float*)F.lds;
    if (Wg) {
        for (int i = F.tid; i < 1024 * 8; i += NTHREADS) wgT[(i & 7) * 1024 + (i >> 3)] = Wg[(size_t)(i >> 3) * MIXN + (i & 7)];
        __syncthreads();
    }
    const int gw = F.bid * 8 + F.wave, NGW = F.G * 8, lane = F.lane;
    f32x4 gpo[4], gpr[4];
#pragma unroll
    for (int j = 0; j < 4; ++j) { gpo[j] = Y ? ((const f32x4*)gpost)[64 * j + lane] * coef : (f32x4){0.f, 0.f, 0.f, 0.f}; gpr[j] = gpre ? ((const f32x4*)gpre)[64 * j + lane] : (f32x4){0.f, 0.f, 0.f, 0.f}; }
    f32x4 gb0 = {0.f, 0.f, 0.f, 0.f}, gb1 = {0.f, 0.f, 0.f, 0.f};
    if (Wg) { gb0 = *(const f32x4*)gate_b; gb1 = *(const f32x4*)(gate_b + 4); }
    constexpr int NR = 2;
    for (int row0 = gw; row0 < M; row0 += NGW * NR) {
        f32x4 v[NR][4]; u32x2 y[NR][4];
#pragma unroll
        for (int r = 0; r < NR; ++r) {
            const int row = row0 + NGW * r, rowc = row < M ? row : row0;
            const f32x4* xr = (const f32x4*)(xsrc + (size_t)rowc * D) + lane;
#pragma unroll
            for (int j = 0; j < 4; ++j) v[r][j] = xr[64 * j];
            if (Y) { const u32x2* yr = (const u32x2*)(Y + (size_t)rowc * D) + lane;
#pragma unroll
                for (int j = 0; j < 4; ++j) y[r][j] = yr[64 * j]; }
            else {
#pragma unroll
                for (int j = 0; j < 4; ++j) y[r][j] = (u32x2){0u, 0u}; }
        }
#pragma unroll
        for (int r = 0; r < NR; ++r) {
            const int row = row0 + NGW * r;
            if (row < M) {
                if (Y) {
                    f32x4 yf[4]; float s = 0.f;
#pragma unroll
                    for (int j = 0; j < 4; ++j) { yf[j] = (f32x4){bf_lo(y[r][j].x), bf_hi(y[r][j].x), bf_lo(y[r][j].y), bf_hi(y[r][j].y)}; s += (yf[j][0] * yf[j][0] + yf[j][1] * yf[j][1]) + (yf[j][2] * yf[j][2] + yf[j][3] * yf[j][3]); }
                    const float rstd = 1.f / sqrtf(wave_sum_dpp(s) * (1.f / D) + EPS);
                    f32x4* xo = (f32x4*)(xdst + (size_t)row * D) + lane;
#pragma unroll
                    for (int j = 0; j < 4; ++j) { v[r][j] = v[r][j] + yf[j] * gpo[j] * rstd; xo[64 * j] = v[r][j]; }
                }
                if (gpre) {
                    float s = 0.f;
#pragma unroll
                    for (int j = 0; j < 4; ++j) s += (v[r][j][0] * v[r][j][0] + v[r][j][1] * v[r][j][1]) + (v[r][j][2] * v[r][j][2] + v[r][j][3] * v[r][j][3]);
                    const float rstd = 1.f / sqrtf(wave_sum_dpp(s) * (1.f / D) + EPS);
                    u32x2* o8 = (u32x2*)(XN + (size_t)row * D) + lane;
#pragma unroll
                    for (int j = 0; j < 4; ++j) { v[r][j] = v[r][j] * gpr[j] * rstd; u32x2 w; w.x = pk2(v[r][j][0], v[r][j][1]); w.y = pk2(v[r][j][2], v[r][j][3]); o8[64 * j] = w; }
                    if (Wg) {
                        float ga[8];
#pragma unroll
                        for (int g = 0; g < 8; ++g) {
                            float a = 0.f;
#pragma unroll
                            for (int j = 0; j < 4; ++j) { const f32x4 w4 = *(const LAS f32x4*)(wgT + g * 1024 + 256 * j + 4 * lane); a += (w4[0] * v[r][j][0] + w4[1] * v[r][j][1]) + (w4[2] * v[r][j][2] + w4[3] * v[r][j][3]); }
                            ga[g] = wave_sum_dpp(a);
                        }
                        if (lane == 0) {
                            f32x4 o0 = {ga[0] + gb0[0], ga[1] + gb0[1], ga[2] + gb0[2], ga[3] + gb0[3]}, o1 = {ga[4] + gb1[0], ga[5] + gb1[1], ga[6] + gb1[2], ga[7] + gb1[3]};
                            *(f32x4*)(gates + (size_t)row * 8) = o0; *(f32x4*)(gates + (size_t)row * 8 + 4) = o1;
                        }
                    }
                }
            }
        }
    }
    if (Wg) __syncthreads();
}

constexpr int I_IN = 16 * 176, I_OUT = 44 * 32, I_MI = 16 * 96, I_MO = 16 * 32;
DI void conv_one(const Ctx& F, int type, int mi, int r, LAS float* scr) {
    const int lane = F.lane;
    if (type == 0) {
        const int kb = r / 176, nb = r % 176, np = 32 * nb, pn = np >> 8, j = np & 255, bj = j >> 7, jj = j & 127;
        transpose_item(F.ffn_w_in + (size_t)mi * D * 2 * DFF, 2 * DFF, D, 64 * kb, bj * DFF + 128 * pn + jj, (bf16_t*)(F.ws + WS_WIN) + (size_t)mi * 2 * DFF * D, np, scr, lane);
    } else if (type == 1) {
        const int kb = r / 32, nb = r % 32;
        transpose_item(F.ffn_w_out + (size_t)mi * DFF * D, D, DFF, 64 * kb, 32 * nb, (bf16_t*)(F.ws + WS_WOUT) + (size_t)mi * D * DFF, 32 * nb, scr, lane);
    } else if (type == 2) {
        const int kb = r / 96, nb = r % 96, np = 32 * nb, region = np >> 9, off = np & 511;
        int src;
        if (region < 2) { const int j = np & 255, bj = j >> 7, jj = j & 127, grp = jj >> 5; src = (np - j) + grp * 64 + bj * 32; }
        else if (region == 2) src = 1536 + off;
        else if (region == 3) src = 2560 + off;
        else if (region == 4) src = 1024 + off;
        else src = 2048 + off;
        transpose_item(F.mix_w_in + (size_t)mi * D * MIXN, MIXN, D, 64 * kb, src, (bf16_t*)(F.ws + WS_WMIXIN) + (size_t)mi * 3072 * D, np, scr, lane);
    } else {
        const int kb = r / 32, nb = r % 32;
        transpose_item(F.mix_w_out + (size_t)mi * D * D, D, D, 64 * kb, 32 * nb, (bf16_t*)(F.ws + WS_WMIXOUT) + (size_t)mi * D * D, 32 * nb, scr, lane);
    }
}
template <int GRP> DI void conv_group(const Ctx& F, int worker, int nworkers, LAS float* scr) {
    constexpr int NSEG = GRP == 0 ? 1 : (GRP == 1 ? 5 : (GRP == 2 ? 4 : 2));
    constexpr int types[4][5] = {{0, 0, 0, 0, 0}, {1, 2, 3, 0, 1}, {0, 1, 2, 3, 0}, {0, 1, 0, 0, 0}};
    constexpr int idxs[4][5] = {{0, 0, 0, 0, 0}, {0, 0, 0, 1, 1}, {2, 2, 1, 1, 0}, {3, 3, 0, 0, 0}};
    constexpr int cnt[4] = {I_IN, I_OUT, I_MI, I_MO};
    int total = 0;
#pragma unroll
    for (int sg = 0; sg < NSEG; ++sg) total += cnt[types[GRP][sg]];
    for (int it = worker; it < total; it += nworkers) {
        int r = it;
#pragma unroll
        for (int sg = 0; sg < NSEG; ++sg) {
            const int n = cnt[types[GRP][sg]];
            if (r >= 0 && r < n) conv_one(F, types[GRP][sg], idxs[GRP][sg], r, scr);
            r -= n;
        }
    }
}

DI void prologue(const Ctx& F) {
    LAS float* scr = (LAS float*)(F.lds + F.wave * 16384);
    const int gw = F.bid * 8 + F.wave, NGW = F.G * 8, lane = F.lane;
    conv_group<0>(F, gw, NGW, scr);
    norm_phase(F, F.x, nullptr, nullptr, nullptr, 0.f, F.norm_g, (bf16_t*)(F.ws + WS_XN), nullptr, nullptr, nullptr);
}

DI float silu_f(float v) { return v / (1.f + __expf(-v)); }
DI bf16x8 ld_bf16x8_g(const bf16_t* p) { return *(const bf16x8*)p; }

DI void m1_phase(const Ctx& F, int l) {
    const int tid = F.tid, lane = F.lane, wave = F.wave;
    LAS bf16_t* KW = (LAS bf16_t*)F.lds;
    LAS float* wl = (LAS float*)(F.lds + 9216);
    const float* MLQK = (const float*)(F.ws + WS_MLQK);
    const float* gates = (const float*)(F.ws + WS_GATES);
    const bf16_t* VT = (const bf16_t*)(F.ws + WS_VTML);
    float* UHAT = (float*)(F.ws + WS_UHAT); float* NHAT = (float*)(F.ws + WS_NHAT);
    float* BCUM = (float*)(F.ws + WS_BCUM); float* LOGI = (float*)(F.ws + WS_LOGI);
    float* CHS = (float*)(F.ws + WS_CHS);
    bf16_t* QC = (bf16_t*)(F.ws + WS_QC); bf16_t* KC = (bf16_t*)(F.ws + WS_KC);
    LAS float* cw = (LAS float*)(F.lds + 16384); LAS float* cb = cw + 2048;
    for (int i = tid; i < 2560; i += NTHREADS) cw[i] = (i < 2048) ? F.conv_w[(size_t)l * 2048 + i] : F.conv_b[(size_t)l * 512 + (i - 2048)];
    __syncthreads();
    const int tl = tid >> 3, d0 = (tid & 7) * 8, r = lane & 31, hh = lane >> 5;
    float gi = 0.f, gf = 0.f; f32x4 xin[2][4][2];
#define M1_ISSUE(U) do { const int bh_ = (U) & 7, c_ = (U) >> 3, b_ = bh_ >> 2, h_ = bh_ & 3, s0_ = c_ * 64, tok0_ = b_ * SEQ + s0_; \
        gi = gates[(size_t)(tok0_ + lane) * 8 + h_]; gf = gates[(size_t)(tok0_ + lane) * 8 + 4 + h_]; \
        _Pragma("unroll") for (int which = 0; which < 2; ++which) _Pragma("unroll") for (int j = 0; j < 4; ++j) { const int s_ = s0_ + tl - 3 + j; \
            const float* xp = MLQK + (size_t)(b_ * SEQ + (s_ < 0 ? 0 : s_)) * 512 + which * 256 + h_ * 64 + d0; \
            xin[which][j][0] = *(const f32x4*)xp; xin[which][j][1] = *(const f32x4*)(xp + 4); } } while (0)
    if (F.bid < 1024) M1_ISSUE(F.bid);
    for (int unit = F.bid; unit < 1024; unit += F.G) {
        const int bh = unit & 7, c = unit >> 3, b = bh >> 2, h = bh & 3, s0 = c * 64, tok0 = b * SEQ + s0;
        bf16x8 vfr[4];
        { const bf16_t* ap = VT + ((size_t)(bh * 128 + 32 * (wave >> 1) + r)) * SEQ + s0 + 8 * hh;
#pragma unroll
          for (int ks = 0; ks < 4; ++ks) vfr[ks] = *(const bf16x8*)(ap + 16 * ks); }
        if (wave == 0) {
            const float lf = fminf(gf, 0.f) - log1pf(__expf(-fabsf(gf)));
            float bc = lf;
#pragma unroll
            for (int o = 1; o < 64; o <<= 1) { const float t = shfl_from(bc, (lane - o) & 63); if (lane >= o) bc += t; }
            const float bl = shfl_from(bc, 63);
            const float a = bl - bc + gi;
            const float amax = wave_max_dpp(a);
            wl[lane] = __expf(a - amax);
            BCUM[bh * SEQ + s0 + lane] = bc; LOGI[bh * SEQ + s0 + lane] = gi;
            if (lane == 0) { CHS[bh * 128 + c] = bl; CHS[1024 + bh * 128 + c] = amax; }
        }
        float kv[8];
#pragma unroll
        for (int which = 0; which < 2; ++which) {
            const int ch = which * 256 + h * 64 + d0;
            float a8[8];
            { const f32x4 b0 = *(const LAS f32x4*)(cb + ch), b1 = *(const LAS f32x4*)(cb + ch + 4);
              a8[0] = b0[0]; a8[1] = b0[1]; a8[2] = b0[2]; a8[3] = b0[3]; a8[4] = b1[0]; a8[5] = b1[1]; a8[6] = b1[2]; a8[7] = b1[3]; }
#pragma unroll
            for (int j = 0; j < 4; ++j) {
                const float keep = (s0 + tl - 3 + j >= 0) ? 1.f : 0.f;
                const f32x4 x0 = xin[which][j][0], x1 = xin[which][j][1];
                const f32x4 w0 = *(const LAS f32x4*)(cw + j * 512 + ch) * keep, w1 = *(const LAS f32x4*)(cw + j * 512 + ch + 4) * keep;
                a8[0] += w0[0] * x0[0]; a8[1] += w0[1] * x0[1]; a8[2] += w0[2] * x0[2]; a8[3] += w0[3] * x0[3];
                a8[4] += w1[0] * x1[0]; a8[5] += w1[1] * x1[1]; a8[6] += w1[2] * x1[2]; a8[7] += w1[3] * x1[3];
            }
            const float sc = which == 0 ? 0.125f : 1.f;
#pragma unroll
            for (int i = 0; i < 8; ++i) a8[i] = silu_f(a8[i]) * sc;
            u32x4 w; w.x = pk2(a8[0], a8[1]); w.y = pk2(a8[2], a8[3]); w.z = pk2(a8[4], a8[5]); w.w = pk2(a8[6], a8[7]);
            bf16_t* dst = (which == 0 ? QC : KC) + ((size_t)bh * SEQ + s0 + tl) * 64 + d0;
            *(u32x4*)dst = w;
            if (which == 1) {
#pragma unroll
                for (int i = 0; i < 8; ++i) kv[i] = a8[i];
            }
        }
        if (unit + F.G < 1024) M1_ISSUE(unit + F.G);
        __syncthreads();
        { const float wt = wl[tl];
#pragma unroll
          for (int i = 0; i < 8; ++i) { const unsigned p = pk2(wt * kv[i], 0.f); KW[(d0 + i) * 72 + tl] = (bf16_t)(p & 0xffffu); } }
        __syncthreads();
        { const int et = wave >> 1, dt = wave & 1;
          f32x16 acc;
#pragma unroll
          for (int i = 0; i < 16; ++i) acc[i] = 0.f;
          const LAS bf16_t* bp = KW + (32 * dt + r) * 72 + 8 * hh;
#pragma unroll
          for (int ks = 0; ks < 4; ++ks) { const bf16x8 bb = *(const LAS bf16x8*)(bp + 16 * ks); acc = MFMA32(vfr[ks], bb, acc); }
          float* up = UHAT + ((size_t)(bh * 128 + c) * 128 + 32 * et) * 64 + 32 * dt + r;
#pragma unroll
          for (int i = 0; i < 16; ++i) up[crow(i, hh) * 64] = acc[i];
        }
        if (tid < 64) {
            float s = 0.f;
#pragma unroll
            for (int q8 = 0; q8 < 8; ++q8) { const u32x4 v = *(const LAS u32x4*)(KW + tid * 72 + 8 * q8);
                s += (bf_lo(v.x) + bf_hi(v.x)) + (bf_lo(v.y) + bf_hi(v.y)) + (bf_lo(v.z) + bf_hi(v.z)) + (bf_lo(v.w) + bf_hi(v.w)); }
            NHAT[(size_t)(bh * 128 + c) * 64 + tid] = s;
        }
        __syncthreads();
    }
}

#undef M1_ISSUE
DI void m2_phase(const Ctx& F, int l) {
    const float* UHAT = (const float*)(F.ws + WS_UHAT); const float* NHAT = (const float*)(F.ws + WS_NHAT);
    bf16_t* CPREV = (bf16_t*)(F.ws + WS_CPREV); float* NPREV = (float*)(F.ws + WS_NPREV);
    float* CHS = (float*)(F.ws + WS_CHS);
    LAS float* sco = (LAS float*)F.lds;
    for (int i = F.tid; i < 2048; i += NTHREADS) sco[i] = CHS[i];
    __syncthreads();
    for (int idx = (F.wave * F.G + F.bid) * 64 + F.lane; idx < 8 * 8256; idx += F.G * NTHREADS) {
        const int bh = idx / 8256, e = idx - bh * 8256;
        const float* __restrict__ src; float* __restrict__ dst = nullptr; bf16_t* __restrict__ dst16 = nullptr; int stride;
        if (e < 8192) { src = UHAT + (size_t)bh * 128 * 8192 + e; dst16 = CPREV + (size_t)bh * 128 * 8192 + e; stride = 8192; }
        else { src = NHAT + (size_t)bh * 128 * 64 + (e - 8192); dst = NPREV + (size_t)bh * 128 * 64 + (e - 8192); stride = 64; }
        const LAS float* bl = sco + bh * 128; const LAS float* am = sco + 1024 + bh * 128; float* mp = CHS + 2048 + bh * 128;
        float m = 0.f, C = 0.f;
        for (int c = 0; c < 128; c += 32) {
            float u[32];
#pragma unroll
            for (int i = 0; i < 32; ++i) u[i] = src[(size_t)(c + i) * stride];
#pragma unroll
            for (int i = 0; i < 32; ++i) {
                if (dst16) dst16[(size_t)(c + i) * stride] = (bf16_t)(pk2(C, 0.f) & 0xffffu); else dst[(size_t)(c + i) * stride] = C;
                if (e == 0) mp[c + i] = m;
                const float blc = bl[c + i], amc = am[c + i];
                const float mn = fmaxf(blc + m, amc);
                C = __expf(blc + m - mn) * C + __expf(amc - mn) * u[i];
                m = mn;
            }
        }
    }
}

DI void m3_phase(const Ctx& F, int l) {
    int tid = F.tid; asm volatile("" : "+v"(tid));
    const int lane = tid & 63, wave = F.wave;
    LAS unsigned char* L = F.lds;
    LAS bf16_t* Qs = (LAS bf16_t*)(L + 0); LAS bf16_t* Ks = (LAS bf16_t*)(L + 9216); LAS bf16_t* VTs = (LAS bf16_t*)(L + 18432); LAS bf16_t* Cs = (LAS bf16_t*)(L + 36864);
    LAS bf16_t* Ws = (LAS bf16_t*)(L + 55296); LAS bf16_t* Qds = (LAS bf16_t*)(L + 64512); LAS float* Hs = (LAS float*)(L + 73728);
    LAS float* vu = (LAS float*)(L + 107520); LAS float* vmm = vu + 64; LAS float* vdec = vu + 128; LAS float* vem = vu + 192; LAS float* vnp = vu + 256; LAS float* vhd = vu + 320;
    const bf16_t* QC = (const bf16_t*)(F.ws + WS_QC); const bf16_t* KC = (const bf16_t*)(F.ws + WS_KC);
    const bf16_t* VT = (const bf16_t*)(F.ws + WS_VTML); const bf16_t* MLO = (const bf16_t*)(F.ws + WS_MLO);
    const bf16_t* CPREV = (const bf16_t*)(F.ws + WS_CPREV); const float* NPREV = (const float*)(F.ws + WS_NPREV);
    const float* BCUM = (const float*)(F.ws + WS_BCUM); const float* LOGI = (const float*)(F.ws + WS_LOGI); const float* CHS = (const float*)(F.ws + WS_CHS);
    bf16_t* YMIX = (bf16_t*)(F.ws + WS_XN);
    LAS float* ng = vu + 384;
    if (tid < 128) ng[tid] = F.ml_norm_g[(size_t)l * 128 + tid];
    __syncthreads();
    const int tl = tid >> 3, d0 = (tid & 7) * 8, r = lane & 31, hh = lane >> 5;
    u32x4 gq, gk, gv[2], gc[2]; float bs = 0.f, li = 0.f, mprev = 0.f, npv = 0.f;
#define M3_ISSUE(U) do { const int bh_ = (U) & 7, c_ = (U) >> 3, s0_ = c_ * 64; \
        gq = *(const u32x4*)(QC + ((size_t)bh_ * SEQ + s0_ + tl) * 64 + d0); gk = *(const u32x4*)(KC + ((size_t)bh_ * SEQ + s0_ + tl) * 64 + d0); \
        _Pragma("unroll") for (int i = 0; i < 2; ++i) { const int idx = tid + NTHREADS * i, e = idx >> 3, ch = idx & 7; \
            gv[i] = *(const u32x4*)(VT + ((size_t)(bh_ * 128 + e)) * SEQ + s0_ + ch * 8); \
            gc[i] = *(const u32x4*)(CPREV + ((size_t)(bh_ * 128 + c_) * 128 + e) * 64 + ch * 8); } \
        bs = BCUM[bh_ * SEQ + s0_ + lane]; li = LOGI[bh_ * SEQ + s0_ + lane]; mprev = CHS[2048 + bh_ * 128 + c_]; \
        npv = NPREV[(size_t)(bh_ * 128 + c_) * 64 + lane]; } while (0)
    if (F.bid < 1024) M3_ISSUE(F.bid);
    for (int unit = F.bid; unit < 1024; unit += F.G) {
        const int bh = unit & 7, c = unit >> 3, b = bh >> 2, h = bh & 3, s0 = c * 64, tok0 = b * SEQ + s0;
        const bf16_t* op = MLO + (size_t)(tok0 + tl) * 512 + h * 128 + (tid & 7) * 16;
        const u32x4 o0 = *(const u32x4*)op, o1 = *(const u32x4*)(op + 8);
        *(LAS u32x4*)(Qs + tl * 72 + d0) = gq; *(LAS u32x4*)(Ks + tl * 72 + d0) = gk;
#pragma unroll
        for (int i = 0; i < 2; ++i) {
            const int idx = tid + NTHREADS * i, e = idx >> 3, ch = idx & 7;
            *(LAS u32x4*)(VTs + e * 72 + ch * 8) = gv[i]; *(LAS u32x4*)(Cs + e * 72 + ch * 8) = gc[i];
        }
        if (wave == 0) {
            const float u = li - bs;
            float pm = u;
#pragma unroll
            for (int o = 1; o < 64; o <<= 1) { const float t = shfl_from(pm, (lane - o) & 63); if (lane >= o) pm = fmaxf(pm, t); }
            const float mm = fmaxf(mprev, pm);
            vu[lane] = u; vmm[lane] = mm; vdec[lane] = __expf(mprev - mm); vem[lane] = __expf(-(bs + mm));
        } else if (wave == 1) {
            vnp[lane] = npv;
        }
        if (unit + F.G < 1024) M3_ISSUE(unit + F.G);
        __syncthreads();
        { const u32x4 q = *(const LAS u32x4*)(Qs + tl * 72 + d0); const float dc = vdec[tl];
          u32x4 w; w.x = pk2(bf_lo(q.x) * dc, bf_hi(q.x) * dc); w.y = pk2(bf_lo(q.y) * dc, bf_hi(q.y) * dc); w.z = pk2(bf_lo(q.z) * dc, bf_hi(q.z) * dc); w.w = pk2(bf_lo(q.w) * dc, bf_hi(q.w) * dc);
          *(LAS u32x4*)(Qds + tl * 72 + d0) = w; }
        if (wave < 4) {
            const int jt = wave >> 1, st = wave & 1;
            f32x16 acc;
#pragma unroll
            for (int i = 0; i < 16; ++i) acc[i] = 0.f;
            const LAS bf16_t* ap = Qs + (32 * jt + r) * 72 + 8 * hh; const LAS bf16_t* bp = Ks + (32 * st + r) * 72 + 8 * hh;
#pragma unroll
            for (int ks = 0; ks < 4; ++ks) acc = MFMA32(*(const LAS bf16x8*)(ap + 16 * ks), *(const LAS bf16x8*)(bp + 16 * ks), acc);
            const int s = 32 * st + r; const float us = vu[s];
#pragma unroll
            for (int i = 0; i < 16; ++i) {
                const int j = 32 * jt + crow(i, hh);
                const float val = (s <= j) ? __expf(us - vmm[j]) * acc[i] : 0.f;
                Ws[j * 72 + s] = (bf16_t)(pk2(val, 0.f) & 0xffffu);
            }
        }
        __syncthreads();
        { const int jt = wave >> 2, et = wave & 3;
          f32x16 acc;
#pragma unroll
          for (int i = 0; i < 16; ++i) acc[i] = 0.f;
          const LAS bf16_t* a1 = Ws + (32 * jt + r) * 72 + 8 * hh; const LAS bf16_t* b1 = VTs + (32 * et + r) * 72 + 8 * hh;
          const LAS bf16_t* a2 = Qds + (32 * jt + r) * 72 + 8 * hh; const LAS bf16_t* b2 = Cs + (32 * et + r) * 72 + 8 * hh;
#pragma unroll
          for (int ks = 0; ks < 4; ++ks) acc = MFMA32(*(const LAS bf16x8*)(a1 + 16 * ks), *(const LAS bf16x8*)(b1 + 16 * ks), acc);
#pragma unroll
          for (int ks = 0; ks < 4; ++ks) acc = MFMA32(*(const LAS bf16x8*)(a2 + 16 * ks), *(const LAS bf16x8*)(b2 + 16 * ks), acc);
#pragma unroll
          for (int i = 0; i < 16; ++i) Hs[(32 * jt + crow(i, hh)) * 132 + 32 * et + r] = acc[i];
        }
        if (tid < 64) {
            float rs = 0.f, qn = 0.f;
#pragma unroll
            for (int q8 = 0; q8 < 8; ++q8) {
                const u32x4 v = *(const LAS u32x4*)(Ws + tid * 72 + 8 * q8);
                rs += (bf_lo(v.x) + bf_hi(v.x)) + (bf_lo(v.y) + bf_hi(v.y)) + (bf_lo(v.z) + bf_hi(v.z)) + (bf_lo(v.w) + bf_hi(v.w));
                const u32x4 q = *(const LAS u32x4*)(Qds + tid * 72 + 8 * q8);
                const LAS float* np = vnp + 8 * q8;
                qn += bf_lo(q.x) * np[0] + bf_hi(q.x) * np[1] + bf_lo(q.y) * np[2] + bf_hi(q.y) * np[3] + bf_lo(q.z) * np[4] + bf_hi(q.z) * np[5] + bf_lo(q.w) * np[6] + bf_hi(q.w) * np[7];
            }
            const float den = rs + qn;
            vhd[tid] = 1.f / fmaxf(fabsf(den), vem[tid]);
        }
        __syncthreads();
        { const int j = tl, e0 = (tid & 7) * 16; const float hd = vhd[j];
          f32x4 hv[4]; float ss = 0.f;
#pragma unroll
          for (int i = 0; i < 4; ++i) { hv[i] = *(const LAS f32x4*)(Hs + j * 132 + e0 + 4 * i) * hd; ss += (hv[i][0] * hv[i][0] + hv[i][1] * hv[i][1]) + (hv[i][2] * hv[i][2] + hv[i][3] * hv[i][3]); }
          ss += dpp_f(ss, 0); ss += dpp_f(ss, 1); ss += dpp_f(ss, 2);
          const float rstd = 1.f / sqrtf(ss * (1.f / 128.f) + EPS);
          const unsigned ow[8] = {o0.x, o0.y, o0.z, o0.w, o1.x, o1.y, o1.z, o1.w};
          unsigned res[8];
#pragma unroll
          for (int i = 0; i < 4; ++i) {
              const f32x4 g = *(const LAS f32x4*)(ng + e0 + 4 * i);
              const float oa = bf_lo(ow[2 * i]), ob = bf_hi(ow[2 * i]), oc = bf_lo(ow[2 * i + 1]), od = bf_hi(ow[2 * i + 1]);
              const float v0 = hv[i][0] * rstd * g[0] / (1.f + __expf(-oa)), v1 = hv[i][1] * rstd * g[1] / (1.f + __expf(-ob));
              const float v2 = hv[i][2] * rstd * g[2] / (1.f + __expf(-oc)), v3 = hv[i][3] * rstd * g[3] / (1.f + __expf(-od));
              res[2 * i] = pk2(v0, v1); res[2 * i + 1] = pk2(v2, v3);
          }
          bf16_t* yp = YMIX + (size_t)(tok0 + j) * 1024 + 512 + h * 128 + e0;
          u32x4 w0 = {res[0], res[1], res[2], res[3]}, w1 = {res[4], res[5], res[6], res[7]};
          *(u32x4*)yp = w0; *(u32x4*)(yp + 8) = w1;
        }
        __syncthreads();
    }
}

#undef M3_ISSUE
constexpr float AT_THR = 6.f;
constexpr int AT_STAGE = 36864, AT_K1 = 9216, AT_V = 18432, AT_SG_OFF = LDS_BYTES - 2048;
DI void attn_unit(const Ctx& F, int l, int bh, int qb, float lam) {
    const int tid = F.tid, lane = F.lane, wave = F.wave, c = wave >> 2, rg = wave & 3, r = lane & 31, hh = lane >> 5;
    const int b = bh >> 2, h = bh & 3;
    LAS unsigned char* L = F.lds;
    const bf16_t* Qg = (const bf16_t*)(F.ws + WS_Q); const bf16_t* Kg = (const bf16_t*)(F.ws + WS_K); const bf16_t* VTg = (const bf16_t*)(F.ws + WS_VTDA);
    bf16_t* YMIX = (bf16_t*)(F.ws + WS_XN);
    const int q0 = qb * 128 + rg * 32;
    bf16x8 qf[4];
    { const bf16_t* qp = Qg + ((size_t)((bh * 2 + c) * SEQ) + q0 + r) * 64 + 8 * hh;
#pragma unroll
      for (int ks = 0; ks < 4; ++ks) qf[ks] = *(const bf16x8*)(qp + 16 * ks); }
    const int ntile = 2 * qb + 2, my_n = (rg < 2) ? ntile - 1 : ntile;
    const int krow = tid >> 3, kch = tid & 7;
    const bf16_t* k0p = Kg + ((size_t)((bh * 2 + 0) * SEQ) + krow) * 64 + kch * 8;
    const bf16_t* k1p = Kg + ((size_t)((bh * 2 + 1) * SEQ) + krow) * 64 + kch * 8;
    const bf16_t* v0p = VTg + ((size_t)(bh * 128 + krow)) * SEQ + kch * 8;
    const bf16_t* v1p = VTg + ((size_t)(bh * 128 + 64 + krow)) * SEQ + kch * 8;
    const int kdst = krow * 144 + kch * 16;
    u32x4 pk0, pk1, pv0, pv1;
    pk0 = *(const u32x4*)k0p; pk1 = *(const u32x4*)k1p; pv0 = *(const u32x4*)v0p; pv1 = *(const u32x4*)v1p;
    *(LAS u32x4*)(L + kdst) = pk0; *(LAS u32x4*)(L + AT_K1 + kdst) = pk1; *(LAS u32x4*)(L + AT_V + kdst) = pv0; *(LAS u32x4*)(L + AT_V + 64 * 144 + kdst) = pv1;
    if (ntile > 1) { pk0 = *(const u32x4*)(k0p + 64 * 64); pk1 = *(const u32x4*)(k1p + 64 * 64); pv0 = *(const u32x4*)(v0p + 64); pv1 = *(const u32x4*)(v1p + 64); }
    __syncthreads();
    f32x16 o[4];
#pragma unroll
    for (int dt = 0; dt < 4; ++dt)
#pragma unroll
        for (int i = 0; i < 16; ++i) o[dt][i] = 0.f;
    float m_run = -30.f, l_run = 0.f;
    bf16x8 pb[4];
#pragma unroll
    for (int i = 0; i < 4; ++i) pb[i] = (bf16x8){0, 0, 0, 0, 0, 0, 0, 0};
    const int kap = (r & ~12) | ((r & 4) << 1) | ((r & 8) >> 1);
    const int koff = c * AT_K1 + kap * 144 + 16 * hh, voff = AT_V + r * 144 + 16 * hh;
#define AT_STAGE_STEP(tw) do { if ((tw) < ntile) { LAS unsigned char* S2 = L + ((tw) & 1) * AT_STAGE; \
        *(LAS u32x4*)(S2 + kdst) = pk0; *(LAS u32x4*)(S2 + AT_K1 + kdst) = pk1; *(LAS u32x4*)(S2 + AT_V + kdst) = pv0; *(LAS u32x4*)(S2 + AT_V + 64 * 144 + kdst) = pv1; \
        if ((tw) + 1 < ntile) { const size_t ko = (size_t)((tw) + 1) * 64 * 64, vo = (size_t)((tw) + 1) * 64; \
            pk0 = *(const u32x4*)(k0p + ko); pk1 = *(const u32x4*)(k1p + ko); pv0 = *(const u32x4*)(v0p + vo); pv1 = *(const u32x4*)(v1p + vo); } } } while (0)
    if (c == 1) __syncthreads();
    for (int t = 0; t < ntile; ++t) {
        LAS unsigned char* S = L + (t & 1) * AT_STAGE;
        if (c == 1) AT_STAGE_STEP(t + 1);
        {
            f32x16 p0, p1;
            const float ninit = (t < my_n) ? -m_run : -1e30f;
#pragma unroll
            for (int i = 0; i < 16; ++i) { p0[i] = ninit; p1[i] = ninit; }
#pragma unroll
            for (int ks = 0; ks < 4; ++ks) { const bf16x8 ka = *(const LAS bf16x8*)(S + koff + 32 * ks); p0 = MFMA32(ka, qf[ks], p0); }
#pragma unroll
            for (int ks = 0; ks < 4; ++ks) { const bf16x8 kb = *(const LAS bf16x8*)(S + koff + 32 * 144 + 32 * ks); p1 = MFMA32(kb, qf[ks], p1); }
            float mx0 = max3f(p0[0], p0[1], p0[2]);
#pragma unroll
            for (int i = 3; i < 15; i += 2) mx0 = max3f(mx0, p0[i], p0[i + 1]);
            mx0 = fmaxf(mx0, p0[15]);
            float ps = 0.f;
#pragma unroll
            for (int i = 0; i < 16; ++i) { p0[i] = __builtin_amdgcn_exp2f(p0[i]); ps += p0[i]; }
            float mx = max3f(mx0, p1[0], p1[1]);
#pragma unroll
            for (int i = 2; i < 16; i += 2) mx = max3f(mx, p1[i], p1[i + 1]);
            mx = half_max(mx);
            if (__any(mx > AT_THR)) {
                const float delta = fmaxf(mx, 0.f);
                const float alpha = __builtin_amdgcn_exp2f(-delta);
                m_run += delta; l_run *= alpha; ps *= alpha;
#pragma unroll
                for (int i = 0; i < 16; ++i) { p0[i] *= alpha; p1[i] -= delta; }
#pragma unroll
                for (int dt = 0; dt < 4; ++dt)
#pragma unroll
                    for (int i = 0; i < 16; ++i) o[dt][i] *= alpha;
            }
#pragma unroll
            for (int i = 0; i < 16; ++i) { p1[i] = __builtin_amdgcn_exp2f(p1[i]); ps += p1[i]; }
            l_run += ps;
            { u32x4 w;
              w.x = pk2(p0[0], p0[1]); w.y = pk2(p0[2], p0[3]); w.z = pk2(p0[4], p0[5]); w.w = pk2(p0[6], p0[7]); pb[0] = __builtin_bit_cast(bf16x8, w);
              w.x = pk2(p0[8], p0[9]); w.y = pk2(p0[10], p0[11]); w.z = pk2(p0[12], p0[13]); w.w = pk2(p0[14], p0[15]); pb[1] = __builtin_bit_cast(bf16x8, w);
              w.x = pk2(p1[0], p1[1]); w.y = pk2(p1[2], p1[3]); w.z = pk2(p1[4], p1[5]); w.w = pk2(p1[6], p1[7]); pb[2] = __builtin_bit_cast(bf16x8, w);
              w.x = pk2(p1[8], p1[9]); w.y = pk2(p1[10], p1[11]); w.z = pk2(p1[12], p1[13]); w.w = pk2(p1[14], p1[15]); pb[3] = __builtin_bit_cast(bf16x8, w); }
            asm volatile("" : "+v"(pb[0]), "+v"(pb[1]), "+v"(pb[2]), "+v"(pb[3]), "+v"(l_run));
        }
        __syncthreads();
        if (c == 0) AT_STAGE_STEP(t + 1);
#pragma unroll
        for (int st = 0; st < 4; ++st)
#pragma unroll
            for (int dt = 0; dt < 4; ++dt) {
                const bf16x8 va = *(const LAS bf16x8*)(S + voff + dt * 32 * 144 + 32 * st);
                o[dt] = MFMA32(va, pb[st], o[dt]);
            }
        __syncthreads();
    }
    if (c == 0) __syncthreads();
#undef AT_STAGE_STEP
    const float inv = 1.f / half_sum(l_run);
    LAS float* X = (LAS float*)L;
    if (c == 1) {
#pragma unroll
        for (int dt = 0; dt < 4; ++dt)
#pragma unroll
            for (int i = 0; i < 16; ++i) X[(rg * 128 + 32 * dt + crow(i, hh)) * 32 + r] = o[dt][i] * inv;
    }
    __syncthreads();
    if (c == 0) {
        float ss = 0.f;
#pragma unroll
        for (int dt = 0; dt < 4; ++dt)
#pragma unroll
            for (int i = 0; i < 16; ++i) { const float v = o[dt][i] * inv - lam * X[(rg * 128 + 32 * dt + crow(i, hh)) * 32 + r]; o[dt][i] = v; ss += v * v; }
        ss = half_sum(ss);
        const float li = (l == 0) ? 0.2f : 0.35550907f;
        const float rstd = (1.f - li) / sqrtf(ss * (1.f / 128.f) + EPS);
        const LAS float* sg = (const LAS float*)(F.lds + AT_SG_OFF);
        bf16_t* yp = YMIX + (size_t)(b * SEQ + q0 + r) * 1024 + h * 128;
#pragma unroll
        for (int dt = 0; dt < 4; ++dt)
#pragma unroll
            for (int g4 = 0; g4 < 4; ++g4) {
                const int d = 32 * dt + 8 * g4 + 4 * hh;
                const f32x4 g = *(const LAS f32x4*)(sg + d);
                u32x2 w; w.x = pk2(o[dt][4 * g4] * rstd * g[0], o[dt][4 * g4 + 1] * rstd * g[1]); w.y = pk2(o[dt][4 * g4 + 2] * rstd * g[2], o[dt][4 * g4 + 3] * rstd * g[3]);
                *(u32x2*)(yp + d) = w;
            }
    }
    __syncthreads();
}

DI void attn_m3_phase(const Ctx& F, int l) {
    const float* lv = F.da_lambda + (size_t)l * 256;
    const float s1 = wave_sum_dpp(lv[F.lane] * lv[64 + F.lane]), s2 = wave_sum_dpp(lv[128 + F.lane] * lv[192 + F.lane]);
    const float li = (l == 0) ? 0.2f : 0.35550907f;
    const float lam = expf(s1) - expf(s2) + li;
    if (F.tid < 128) ((LAS float*)(F.lds + AT_SG_OFF))[F.tid] = F.da_subln_g[(size_t)l * 128 + F.tid];
    __syncthreads();
    for (int rep = 0; rep < D_AT; ++rep)
    for (int p = F.bid; p < 256; p += F.G) {
        const int bh = p & 7, i = p >> 3;
#if EN_AT
        attn_unit(F, l, bh, 63 - i, lam);
        attn_unit(F, l, bh, i, lam);
#endif
    }
#if EN_M3
    for (int rep = 0; rep < D_M3; ++rep) m3_phase(F, l);
#endif
}


#define XB_TMO      128
#define XB_XCNT(j)  (256  + 64 * (j))
#define XB_XSUB(j)  (1280 + 64 * (j))
#define XB_XGEN(j)  (2304 + 64 * (j))
#define XB_TOP      3328
#define XB_TOPGEN   3392
#define XCD_BAR_WORDS 3456
#define XB_SPIN_CAP (1u << 22)
DI unsigned xb_ld(unsigned* p)              { return __hip_atomic_load(p, __ATOMIC_RELAXED, __HIP_MEMORY_SCOPE_AGENT); }
DI unsigned xb_add(unsigned* p, unsigned v) { return __hip_atomic_fetch_add(p, v, __ATOMIC_RELAXED, __HIP_MEMORY_SCOPE_AGENT); }
DI unsigned xb_xcc_id() { return (unsigned)__builtin_amdgcn_s_getreg((3 << 11) | 20) & 0xFu; }
#define XB_SPIN(cond, bar) do { unsigned _sp = 0; while (cond) { __builtin_amdgcn_s_sleep(1); \
    if ((++_sp & 255u) == 0u) { if (xb_ld(&(bar)[XB_TMO])) break; if (_sp > XB_SPIN_CAP) { atomicAdd(&(bar)[XB_TMO], 1u); break; } } } } while (0)
struct XcdBarrier { unsigned* bar; unsigned x; volatile LAS unsigned* st; };
DI XcdBarrier xcd_barrier_post(unsigned* bar, volatile LAS unsigned* st) {
    XcdBarrier b; b.bar = bar; b.x = xb_xcc_id(); b.st = st;
    if (threadIdx.x == 0) (void)xb_add(&bar[XB_XCNT(b.x)], 1u);
    return b;
}
DI void xcd_barrier_complete(unsigned* bar, unsigned x, unsigned& nloc, unsigned& nx) {
    const unsigned G = gridDim.x * gridDim.y * gridDim.z;
    unsigned sum, cnt, mine, sp = 0u;
    for (;;) {
        sum = 0u; cnt = 0u; mine = 0u;
#pragma unroll
        for (unsigned j = 0; j < 16; ++j) { const unsigned c = xb_ld(&bar[XB_XCNT(j)]); sum += c; cnt += (c > 0u) ? 1u : 0u; mine = (j == x) ? c : mine; }
        if (sum == G) break;
        __builtin_amdgcn_s_sleep(1);
        if ((++sp & 255u) == 0u) { if (xb_ld(&bar[XB_TMO])) break; if (sp > XB_SPIN_CAP) { atomicAdd(&bar[XB_TMO], 1u); break; } }
    }
    nloc = mine > 0u ? mine : 1u; nx = cnt > 0u ? cnt : 1u;
}
DI void xcd_barrier(const XcdBarrier& b) {
    asm volatile("s_waitcnt vmcnt(0)" ::: "memory");
    __syncthreads();
    if (threadIdx.x == 0) {
        unsigned* bar = b.bar;
        __builtin_amdgcn_s_waitcnt(0);
        unsigned nloc = b.st[0], nx = b.st[1];
        if (nloc == 0u) { xcd_barrier_complete(bar, b.x, nloc, nx); b.st[0] = nloc; b.st[1] = nx; }
        const unsigned old = xb_add(&bar[XB_XSUB(b.x)], 1u);
        const unsigned gen = old / nloc;
        if (old + 1u == (gen + 1u) * nloc) {
            __builtin_amdgcn_fence(__ATOMIC_RELEASE, "agent");
            asm volatile("s_waitcnt vmcnt(0)" ::: "memory");
            const unsigned og = xb_add(&bar[XB_TOP], 1u);
            const unsigned tg = og / nx;
            if (og + 1u == (tg + 1u) * nx) xb_add(&bar[XB_TOPGEN], 1u);
            else XB_SPIN(xb_ld(&bar[XB_TOPGEN]) == tg, bar);
            __builtin_amdgcn_fence(__ATOMIC_ACQUIRE, "agent");
            xb_add(&bar[XB_XGEN(b.x)], 1u);
            asm volatile("s_waitcnt vmcnt(0)" ::: "memory");
        } else {
            XB_SPIN(xb_ld(&bar[XB_XGEN(b.x)]) == gen, bar);
            __builtin_amdgcn_fence(__ATOMIC_ACQUIRE, "agent");
            asm volatile("s_waitcnt vmcnt(0)" ::: "memory");
        }
    }
    __syncthreads();
}

__global__ void __launch_bounds__(NTHREADS, 2) fwd_kernel(Args args) {
    extern __shared__ __attribute__((aligned(16))) unsigned char lds_raw[];
    unsigned char* ws = args.ws;
    bf16_t* XN = (bf16_t*)(ws + WS_XN); bf16_t* ACT = (bf16_t*)(ws + WS_A); bf16_t* Y = (bf16_t*)(ws + WS_Y);
    volatile LAS unsigned* bst = (volatile LAS unsigned*)((LAS unsigned char*)lds_raw + LDS_BYTES - 64);
    if (threadIdx.x < 2) bst[threadIdx.x] = 0u;
    __syncthreads();
    XcdBarrier xbar = xcd_barrier_post((unsigned*)(args.ws + WS_BAR), bst);
    int probe_rep = 0;
    for (int ph = args.ph_lo; ph < args.ph_hi; ++ph) {
        Ctx F;
        F.lds = (LAS unsigned char*)lds_raw;
        { int t = threadIdx.x; asm volatile("" : "+v"(t)); F.tid = t; }
        F.lane = F.tid & 63; F.wave = __builtin_amdgcn_readfirstlane(F.tid >> 6);
        { int bb = blockIdx.x; asm volatile("" : "+s"(bb)); F.bid = bb; }
        F.G = gridDim.x;
        F.x = args.in[0]; F.ffn_w_in = args.in[1]; F.ffn_w_out = args.in[2]; F.norm_g = args.in[3]; F.mix_w_in = args.in[4]; F.mix_w_out = args.in[5];
        F.da_lambda = args.in[6]; F.da_subln_g = args.in[7]; F.conv_w = args.in[8]; F.conv_b = args.in[9]; F.gate_b = args.in[10]; F.ml_norm_g = args.in[11];
        F.out = args.out; F.ws = args.ws;
        if (ph == 0) {
#if EN_PRO
            for (int rep = 0; rep < D_PRO; ++rep) prologue(F);
#endif
        } else {
            const int l = (ph - 1) / 12, k = (ph - 1) % 12;
            const float* ng = F.norm_g + (size_t)l * 6 * D;
            if (k == 0 || k == 9) {
                const int s = (k == 0) ? 0 : 1;
                pg8::Gemm g{XN, (const bf16_t*)(ws + WS_WIN) + (size_t)(l * 2 + s) * 2 * DFF * D, M, 2 * DFF, D};
                pg8::StaticOrder S; S.init(M, 2 * DFF, F.G, F.bid);
                pg8::EpiSwiglu E{ACT};
#if EN_G1
                for (int rep = 0; rep < D_G1; ++rep) pg8::gemm_phase<pg8::EpiSwiglu>(F.lds, F.tid, g, S, E);
#endif
                {
                    const int nun = (M / 256) * (2 * DFF / 256), rem = nun % F.G, first = rem ? rem : 0, nidle = F.G - first;
                    if (F.bid >= first) {
                        LAS float* scr = (LAS float*)(F.lds + F.wave * 16384);
                        const int worker = (F.bid - first) * 8 + F.wave, nworkers = nidle * 8;
                        if (l == 0 && k == 0) conv_group<1>(F, worker, nworkers, scr);
                        else if (l == 0 && k == 9) conv_group<2>(F, worker, nworkers, scr);
                        else if (l == 1 && k == 0) conv_group<3>(F, worker, nworkers, scr);
                    }
                }
            } else if (k == 1 || k == 10 || k == 7) {
                pg8::Gemm g;
                if (k == 7) g = pg8::Gemm{XN, (const bf16_t*)(ws + WS_WMIXOUT) + (size_t)l * D * D, M, D, D};
                else g = pg8::Gemm{ACT, (const bf16_t*)(ws + WS_WOUT) + (size_t)(l * 2 + (k == 1 ? 0 : 1)) * D * DFF, M, D, DFF};
                pg8::StaticOrder S; S.init(M, D, F.G, F.bid);
                pg8::EpiBf16 E{Y, D};
#if EN_G2
                for (int rep = 0; rep < D_G2; ++rep) pg8::gemm_phase<pg8::EpiBf16>(F.lds, F.tid, g, S, E);
#endif
            } else if (k == 2 || k == 8 || k == 11) {
                const float* xsrc = (l == 0 && k == 2) ? F.x : F.out;
                const float* gpost = ng + (k == 2 ? 1 : (k == 8 ? 3 : 5)) * D;
                const float coef = (k == 8) ? 1.f : 0.5f;
                const float* gpre = (k == 2) ? ng + 2 * D : (k == 8 ? ng + 4 * D : (l + 1 < NL ? F.norm_g + (size_t)(l + 1) * 6 * D : nullptr));
                const bool wg = (k == 2);
#if EN_N
                norm_phase(F, xsrc, F.out, Y, gpost, coef, gpre, XN, wg ? F.mix_w_in + (size_t)l * D * MIXN + 3072 : nullptr, F.gate_b + l * 8, (float*)(ws + WS_GATES));
#endif
            } else if (k == 3) {
                const bf16_t* Wt = (const bf16_t*)(ws + WS_WMIXIN) + (size_t)l * 3072 * D;
                { pg8::Gemm g{XN, Wt + (size_t)2048 * D, M, 1024, D}; pg8::StaticOrder S; S.init(M, 1024, F.G, F.bid);
                  pg8::EpiVT E{(bf16_t*)(ws + WS_VTDA), (bf16_t*)(ws + WS_VTML)};
#if EN_G3A
                  for (int rep = 0; rep < D_G3; ++rep) pg8::gemm_phase<pg8::EpiVT>(F.lds, F.tid, g, S, E);
#endif
                }
                { pg8::Gemm g{XN, Wt, M, 2048, D}; pg8::StaticOrder S; S.init(M, 2048, F.G, F.bid);
                  pg8::EpiMix E{(bf16_t*)(ws + WS_Q), (bf16_t*)(ws + WS_K), (float*)(ws + WS_MLQK), (bf16_t*)(ws + WS_MLO)};
#if EN_G3B
                  for (int rep = 0; rep < D_G3; ++rep) pg8::gemm_phase<pg8::EpiMix>(F.lds, F.tid, g, S, E);
#endif
                }
            } else if (k == 4) {
#if EN_M1
                for (int rep = 0; rep < D_M1; ++rep) m1_phase(F, l);
#endif
            } else if (k == 5) {
#if EN_M2
                for (int rep = 0; rep < D_M2; ++rep) m2_phase(F, l);
#endif
            } else if (k == 6) {
                attn_m3_phase(F, l);
            }
        }
        if (PROBE_MASK) {
            const int kk = (ph == 0) ? 12 : (ph - 1) % 12;
            if (((PROBE_MASK >> kk) & 1) && !probe_rep) { probe_rep = 1; --ph; } else probe_rep = 0;
        }
        if (ph + 1 < args.ph_hi) {
            if (args.ph_hi > 4096) cg::this_grid().sync();
            else xcd_barrier(xbar);
        }
    }
}

constexpr int NPHASES = 1 + 12 * NL;

extern "C" void kernel_launch(void* const* d_in, const int* in_sizes, int n_in, void* d_out, int out_size, void* d_ws, size_t ws_size, hipStream_t stream) {
    static int grid = 0;
    if (grid == 0) {
        if (n_in != 12 || in_sizes[0] != M * D || out_size != M * D || ws_size < WS_END) {
            fprintf(stderr, "kernel_launch: unexpected shapes: n_in %d in0 %d out %d ws %zu (need %zu)\n", n_in, n_in > 0 ? in_sizes[0] : -1, out_size, ws_size, (size_t)WS_END); grid = -1; return; }
        int dev = 0, cus = 0, per_cu = 0;
        hipGetDevice(&dev);
        hipDeviceGetAttribute(&cus, hipDeviceAttributeMultiprocessorCount, dev);
        if (hipFuncSetAttribute((const void*)fwd_kernel, hipFuncAttributeMaxDynamicSharedMemorySize, LDS_BYTES) != hipSuccess) { fprintf(stderr, "kernel_launch: hipFuncSetAttribute failed\n"); grid = -1; return; }
        if (hipOccupancyMaxActiveBlocksPerMultiprocessor(&per_cu, (const void*)fwd_kernel, NTHREADS, LDS_BYTES) != hipSuccess || per_cu < 1) { fprintf(stderr, "kernel_launch: occupancy query says %d\n", per_cu); per_cu = 1; }
        (void)hipGetLastError();
        grid = cus * 1;
        if (grid <= 0) grid = 256;
    }
    if (grid < 0) return;
    if (hipMemsetAsync((char*)d_ws + WS_BAR, 0, 16384, stream) != hipSuccess) { fprintf(stderr, "kernel_launch: memset failed\n"); return; }
    Args a{};
    for (int i = 0; i < 12; ++i) a.in[i] = (const float*)d_in[i];
    a.out = (float*)d_out; a.ws = (unsigned char*)d_ws;
#if ONE_LAUNCH
    a.ph_lo = 0; a.ph_hi = NPHASES;
    void* kargs[] = {&a};
    hipError_t e = hipLaunchCooperativeKernel((const void*)fwd_kernel, dim3(grid), dim3(NTHREADS), kargs, LDS_BYTES, stream);
    if (e != hipSuccess) fprintf(stderr, "kernel_launch: cooperative launch failed: %s (grid %d)\n", hipGetErrorString(e), grid);
#else
    for (int ph = 0; ph < NPHASES; ++ph) {
        a.ph_lo = ph; a.ph_hi = ph + 1;
        hipLaunchKernelGGL(fwd_kernel, dim3(grid), dim3(NTHREADS), LDS_BYTES, stream, a);
    }
#endif
}
```

```cpp
#include <hip/hip_runtime.h>
#include <hip/hip_cooperative_groups.h>
#include <cstdio>
#include <cstdint>
namespace cg = cooperative_groups;

#ifndef ONE_LAUNCH
#define ONE_LAUNCH 1
#endif

#ifndef D_PRO
#define D_PRO 1
#endif
#ifndef D_G1
#define D_G1 1
#endif
#ifndef D_G2
#define D_G2 1
#endif
#ifndef D_G3
#define D_G3 1
#endif
#ifndef D_M1
#define D_M1 1
#endif
#ifndef D_M2
#define D_M2 1
#endif
#ifndef D_AT
#define D_AT 1
#endif
#ifndef D_M3
#define D_M3 1
#endif
#ifndef PROBE_MASK
#define PROBE_MASK 0
#endif
#ifndef EN_ALL
#define EN_ALL 1
#endif
#ifndef EN_PRO
#define EN_PRO EN_ALL
#endif
#ifndef EN_G1
#define EN_G1 EN_ALL
#endif
#ifndef EN_G2
#define EN_G2 EN_ALL
#endif
#ifndef EN_N
#define EN_N EN_ALL
#endif
#ifndef EN_G3A
#define EN_G3A EN_ALL
#endif
#ifndef EN_G3B
#define EN_G3B EN_ALL
#endif
#ifndef EN_M1
#define EN_M1 EN_ALL
#endif
#ifndef EN_M2
#define EN_M2 EN_ALL
#endif
#ifndef EN_AT
#define EN_AT EN_ALL
#endif
#ifndef EN_M3
#define EN_M3 EN_ALL
#endif
#define LAS __attribute__((address_space(3)))
#define DI __device__ __forceinline__
typedef unsigned short bf16_t;
typedef short bf16x8 __attribute__((ext_vector_type(8)));
typedef float f32x4 __attribute__((ext_vector_type(4)));
typedef float f32x16 __attribute__((ext_vector_type(16)));
typedef unsigned u32x4 __attribute__((ext_vector_type(4)));
typedef unsigned u32x2 __attribute__((ext_vector_type(2)));
typedef __bf16 bf16x2_t __attribute__((ext_vector_type(2)));
typedef float f32x2_t __attribute__((ext_vector_type(2)));

constexpr int NB = 2, SEQ = 8192, M = NB * SEQ, D = 1024, DFF = 2816, NL = 2;
constexpr int MIXN = 3080;
constexpr float EPS = 1e-6f;
constexpr float LOG2E = 1.4426950408889634f;
constexpr float QSCALE = 0.125f * LOG2E;

constexpr size_t MiB = 1u << 20;
constexpr size_t WS_WIN = 0;
constexpr size_t WS_WOUT = 44 * MiB;
constexpr size_t WS_WMIXIN = 66 * MiB;
constexpr size_t WS_WMIXOUT = 78 * MiB;
constexpr size_t WS_GATES = 84 * MiB;
constexpr size_t WS_BCUM = WS_GATES + 512 * 1024;
constexpr size_t WS_LOGI = WS_BCUM + 256 * 1024;
constexpr size_t WS_NHAT = WS_LOGI + 256 * 1024;
constexpr size_t WS_NPREV = WS_NHAT + 256 * 1024;
constexpr size_t WS_CHS = WS_NPREV + 256 * 1024;
constexpr size_t WS_BAR = WS_CHS + 64 * 1024;
constexpr size_t WS_XN = 86 * MiB;
constexpr size_t WS_A = 118 * MiB;
constexpr size_t WS_Q = WS_A, WS_K = WS_A + 16 * MiB, WS_VTDA = WS_A + 32 * MiB, WS_VTML = WS_A + 48 * MiB, WS_MLO = WS_A + 64 * MiB, WS_QC = WS_A + 80 * MiB, WS_KC = WS_A + 88 * MiB;
constexpr size_t WS_Y = 214 * MiB;
constexpr size_t WS_MLQK = WS_Y, WS_CPREV = WS_Y, WS_UHAT = WS_Y + 32 * MiB;
constexpr size_t WS_END = 278 * MiB;

constexpr int LDS_BYTES = 147456;
constexpr int NTHREADS = 512;

DI unsigned pk2(float lo, float hi) { f32x2_t v = {lo, hi}; bf16x2_t b = __builtin_convertvector(v, bf16x2_t); return __builtin_bit_cast(unsigned, b); }
DI float bf_lo(unsigned u) { return __builtin_bit_cast(float, u << 16); }
DI float bf_hi(unsigned u) { return __builtin_bit_cast(float, u & 0xffff0000u); }
DI float dpp_f(float v, const int ctrl_sel) {
    const int x = __builtin_bit_cast(int, v);
    int r;
    if (ctrl_sel == 0) r = __builtin_amdgcn_update_dpp(0, x, 0xB1, 0xF, 0xF, true);
    else if (ctrl_sel == 1) r = __builtin_amdgcn_update_dpp(0, x, 0x4E, 0xF, 0xF, true);
    else if (ctrl_sel == 2) r = __builtin_amdgcn_update_dpp(0, x, 0x141, 0xF, 0xF, true);
    else r = __builtin_amdgcn_update_dpp(0, x, 0x140, 0xF, 0xF, true);
    return __builtin_bit_cast(float, r);
}
DI float wave_sum_dpp(float v) {
    v += dpp_f(v, 0); v += dpp_f(v, 1); v += dpp_f(v, 2); v += dpp_f(v, 3);
    { auto rr = __builtin_amdgcn_permlane16_swap(__builtin_bit_cast(unsigned, v), __builtin_bit_cast(unsigned, v), false, false);
      v = __builtin_bit_cast(float, (unsigned)rr[0]) + __builtin_bit_cast(float, (unsigned)rr[1]); }
    { auto rr = __builtin_amdgcn_permlane32_swap(__builtin_bit_cast(unsigned, v), __builtin_bit_cast(unsigned, v), false, false);
      v = __builtin_bit_cast(float, (unsigned)rr[0]) + __builtin_bit_cast(float, (unsigned)rr[1]); }
    return v;
}
DI float wave_max_dpp(float v) {
    v = fmaxf(v, dpp_f(v, 0)); v = fmaxf(v, dpp_f(v, 1)); v = fmaxf(v, dpp_f(v, 2)); v = fmaxf(v, dpp_f(v, 3));
    { auto rr = __builtin_amdgcn_permlane16_swap(__builtin_bit_cast(unsigned, v), __builtin_bit_cast(unsigned, v), false, false);
      v = fmaxf(__builtin_bit_cast(float, (unsigned)rr[0]), __builtin_bit_cast(float, (unsigned)rr[1])); }
    { auto rr = __builtin_amdgcn_permlane32_swap(__builtin_bit_cast(unsigned, v), __builtin_bit_cast(unsigned, v), false, false);
      v = fmaxf(__builtin_bit_cast(float, (unsigned)rr[0]), __builtin_bit_cast(float, (unsigned)rr[1])); }
    return v;
}
DI float half_sum(float v) { auto rr = __builtin_amdgcn_permlane32_swap(__builtin_bit_cast(unsigned, v), __builtin_bit_cast(unsigned, v), false, false);
    return __builtin_bit_cast(float, (unsigned)rr[0]) + __builtin_bit_cast(float, (unsigned)rr[1]); }
DI float half_max(float v) { auto rr = __builtin_amdgcn_permlane32_swap(__builtin_bit_cast(unsigned, v), __builtin_bit_cast(unsigned, v), false, false);
    return fmaxf(__builtin_bit_cast(float, (unsigned)rr[0]), __builtin_bit_cast(float, (unsigned)rr[1])); }
DI float shfl_from(float v, int src_lane) { return __builtin_bit_cast(float, __builtin_amdgcn_ds_bpermute(src_lane << 2, __builtin_bit_cast(int, v))); }
DI int crow(int reg, int h) { return (reg & 3) + 8 * (reg >> 2) + 4 * h; }
DI float max3f(float a, float b, float c) { float r; asm("v_max3_f32 %0, %1, %2, %3" : "=v"(r) : "v"(a), "v"(b), "v"(c)); return r; }
#define MFMA32(a, b, c) __builtin_amdgcn_mfma_f32_32x32x16_bf16((a), (b), (c), 0, 0, 0)

namespace pg8 {
constexpr int BM = 256, BK = 64, HALF = 128, HTB = HALF * BK * 2, STAGE_BYTES = 8 * HTB, NXCD = 8, WGM = 8;
DI int lds_byte(int r, int c) { const int st = (r >> 4) * 2 + (c >> 5), rr = r & 15, cc = c & 31, ob = rr * 64 + cc * 2; return st * 1024 + (ob ^ (((ob >> 9) & 1) << 5)); }
DI void stage_rc(int b, int& R, int& C) { const int st = b / 1024, sb = b % 1024, swz = sb ^ (((sb >> 9) & 1) << 5); R = (st >> 1) * 16 + swz / 64; C = (st & 1) * 32 + (swz % 64) / 2; }
DI int perm32(int rho) { const int n = rho >> 4, i = rho & 15; return 8 * (i >> 2) + 4 * n + (i & 3); }
struct Unit { int pm, pn; };
struct Gemm { const bf16_t* A; const bf16_t* Bt; int M, N, K; };
struct StaticOrder {
    int nM, nN, nwg, G, c;
    DI void init(int M_, int N_, int G_, int c_) { nM = M_ / BM; nN = N_ / BM; nwg = nM * nN; G = G_; c = c_; }
    DI bool next(int i, Unit& u) const {
        const long L = (long)i * G + c; if (L >= nwg) return false;
        int wgid = (int)L; { const int q = nwg / NXCD, r = nwg % NXCD, xcd = wgid % NXCD, off = wgid / NXCD; wgid = (xcd < r ? xcd * (q + 1) : r * (q + 1) + (xcd - r) * q) + off; }
        const int nig = WGM * nN, gid = wgid / nig, fm = gid * WGM, gsz = (nM - fm) < WGM ? (nM - fm) : WGM;
        u.pm = fm + ((wgid % nig) % gsz); u.pn = (wgid % nig) / gsz; return true;
    }
};

template <class Epi>
DI void gemm_phase(LAS unsigned char* lds, const int tid, const Gemm g, const StaticOrder& S, const Epi& E) {
    const int wid = __builtin_amdgcn_readfirstlane(tid >> 6), lane = tid & 63, wr = wid >> 2, wc = wid & 3, fr = lane & 15, fq = lane >> 4;
    const int K = g.K, nt = K / BK;
    unsigned voffA[2], voffB[2];
#pragma unroll
    for (int i = 0; i < 2; ++i) { int R, C; stage_rc(tid * 16 + i * 8192, R, C); const int Rb = Epi::PERM ? ((R & ~31) + perm32(R & 31)) : R;
        voffA[i] = (unsigned)(R * K + C) * 2u; voffB[i] = (unsigned)(Rb * K + C) * 2u; }
    const size_t kstep = (size_t)(BK * 2);
    const size_t hstep = (size_t)HALF * K * 2;
    const size_t tstep = 2 * hstep;
    const unsigned ldsw = (unsigned)wid * 1024u;
    const int aoff = lds_byte(wr * 64 + fr, fq * 8), boff = lds_byte(wc * 32 + fr, fq * 8);
#define PG8_SA(b, h) (((b) * 2 + (h)) * HTB)
#define PG8_SB(b, h) ((4 + (b) * 2 + (h)) * HTB)
#define PG8_STAGE(bufoff, gbase, voff) do { _Pragma("unroll") for (int _i = 0; _i < 2; ++_i) \
        __builtin_amdgcn_global_load_lds((const unsigned*)((const char*)(gbase) + (voff)[_i]), (LAS unsigned*)(lds + (bufoff) + ldsw + _i * 8192), 16, 0, 0); } while (0)
#define PG8_LDA(dst, b, h) do { _Pragma("unroll") for (int m = 0; m < 4; ++m) _Pragma("unroll") for (int k = 0; k < 2; ++k) dst[m][k] = *(const LAS bf16x8*)(lds + PG8_SA(b, h) + aoff + m * 2048 + k * 1024); } while (0)
#define PG8_LDB(dst, b, h) do { _Pragma("unroll") for (int n = 0; n < 2; ++n) _Pragma("unroll") for (int k = 0; k < 2; ++k) dst[n][k] = *(const LAS bf16x8*)(lds + PG8_SB(b, h) + boff + n * 2048 + k * 1024); } while (0)
#define PG8_MMA(ai, bj, At, Bt) do { __builtin_amdgcn_s_setprio(1); _Pragma("unroll") for (int m = 0; m < 4; ++m) _Pragma("unroll") for (int n = 0; n < 2; ++n) _Pragma("unroll") for (int k = 0; k < 2; ++k) \
        acc[ai][bj][m][n] = Epi::TRANS ? __builtin_amdgcn_mfma_f32_16x16x32_bf16(Bt[n][k], At[m][k], acc[ai][bj][m][n], 0, 0, 0) \
                                       : __builtin_amdgcn_mfma_f32_16x16x32_bf16(At[m][k], Bt[n][k], acc[ai][bj][m][n], 0, 0, 0); __builtin_amdgcn_s_setprio(0); } while (0)
#define PG8_WAIT_V(n) asm volatile("s_waitcnt vmcnt(" #n ")" ::: "memory")
#define PG8_WAIT_L(n) asm volatile("s_waitcnt lgkmcnt(" #n ")" ::: "memory")
#define PG8_BAR __builtin_amdgcn_s_barrier()
#define PG8_SCHED __builtin_amdgcn_sched_barrier(0)
    Unit cur, nxt; int ui = 0;
    if (!S.next(0, cur)) return;
    f32x4 acc[2][2][4][2];
#pragma unroll
    for (int a = 0; a < 2; ++a)
#pragma unroll
        for (int b = 0; b < 2; ++b)
#pragma unroll
            for (int m = 0; m < 4; ++m)
#pragma unroll
                for (int n = 0; n < 2; ++n) acc[a][b][m][n] = (f32x4){0.f, 0.f, 0.f, 0.f};
    bf16x8 At[4][2], B0[2][2], B1[2][2];
    const char* cA = (const char*)g.A + (size_t)cur.pm * tstep; const char* cB = (const char*)g.Bt + (size_t)cur.pn * tstep;
    PG8_STAGE(PG8_SB(0, 0), cB, voffB); PG8_STAGE(PG8_SB(0, 1), cB + hstep, voffB); PG8_STAGE(PG8_SA(0, 0), cA, voffA); PG8_STAGE(PG8_SA(0, 1), cA + hstep, voffA);
    if (wr == 1) PG8_BAR;
    PG8_WAIT_V(2); PG8_BAR;
    PG8_STAGE(PG8_SB(1, 0), cB + kstep, voffB); PG8_STAGE(PG8_SA(1, 0), cA + kstep, voffA); PG8_STAGE(PG8_SB(1, 1), cB + hstep + kstep, voffB);
    PG8_WAIT_V(6); PG8_BAR;
    for (;;) {
        const bool has_next = S.next(ui + 1, nxt);
        const char* nA = has_next ? (const char*)g.A + (size_t)nxt.pm * tstep : cA; const char* nB = has_next ? (const char*)g.Bt + (size_t)nxt.pn * tstep : cB;
        for (int t = 0; t < nt; t += 2) {
            const bool last = (t == nt - 2);
            const char* a1 = cA + (size_t)(t + 1) * kstep;
            const char* a2 = last ? nA : cA + (size_t)(t + 2) * kstep; const char* b2 = last ? nB : cB + (size_t)(t + 2) * kstep;
            const char* a3 = a2 + kstep; const char* b3 = b2 + kstep;
            PG8_LDB(B0, 0, 0); PG8_LDB(B1, 0, 1); PG8_SCHED; PG8_LDA(At, 0, 0); PG8_STAGE(PG8_SA(1, 1), a1 + hstep, voffA);
            PG8_WAIT_V(8); PG8_WAIT_L(0); PG8_BAR; PG8_MMA(0, 0, At, B0); PG8_MMA(0, 1, At, B1); PG8_BAR; PG8_SCHED;
            PG8_LDA(At, 0, 1); PG8_STAGE(PG8_SB(0, 0), b2, voffB); PG8_STAGE(PG8_SB(0, 1), b2 + hstep, voffB); PG8_STAGE(PG8_SA(0, 0), a2, voffA);
            PG8_WAIT_V(8); PG8_WAIT_L(0); PG8_BAR; PG8_MMA(1, 0, At, B0); PG8_MMA(1, 1, At, B1); PG8_BAR; PG8_SCHED;
            PG8_LDB(B0, 1, 0); PG8_LDB(B1, 1, 1); PG8_SCHED; PG8_LDA(At, 1, 0); PG8_STAGE(PG8_SA(0, 1), a2 + hstep, voffA);
            PG8_WAIT_V(8); PG8_WAIT_L(0); PG8_BAR; PG8_MMA(0, 0, At, B0); PG8_MMA(0, 1, At, B1); PG8_BAR; PG8_SCHED;
            PG8_LDA(At, 1, 1); PG8_STAGE(PG8_SB(1, 0), b3, voffB); PG8_STAGE(PG8_SB(1, 1), b3 + hstep, voffB); PG8_STAGE(PG8_SA(1, 0), a3, voffA);
            PG8_WAIT_V(8); PG8_WAIT_L(0); PG8_BAR; PG8_MMA(1, 0, At, B0); PG8_MMA(1, 1, At, B1); PG8_BAR; PG8_SCHED;
        }
        if (wr == 0) PG8_BAR;
        E(acc, cur, wr, wc, fr, fq);
        if (!has_next) break;
#pragma unroll
        for (int a = 0; a < 2; ++a)
#pragma unroll
            for (int b = 0; b < 2; ++b)
#pragma unroll
                for (int m = 0; m < 4; ++m)
#pragma unroll
                    for (int n = 0; n < 2; ++n) acc[a][b][m][n] = (f32x4){0.f, 0.f, 0.f, 0.f};
        cur = nxt; cA = nA; cB = nB; ++ui;
        if (wr == 1) PG8_BAR;
    }
    PG8_WAIT_V(0);
    PG8_BAR;
#undef PG8_SA
#undef PG8_SB
#undef PG8_STAGE
#undef PG8_LDA
#undef PG8_LDB
#undef PG8_MMA
#undef PG8_WAIT_V
#undef PG8_WAIT_L
#undef PG8_BAR
#undef PG8_SCHED
}

DI float silu_mul(float g, float u) { return g * __builtin_amdgcn_rcpf(1.f + __builtin_amdgcn_exp2f(-g * LOG2E)) * u; }

struct EpiSwiglu {
    static constexpr bool PERM = true, TRANS = true;
    bf16_t* O;
    DI void operator()(const f32x4 (&acc)[2][2][4][2], const Unit& u, int wr, int wc, int fr, int fq) const {
        const int row0 = u.pm * BM + wr * 64 + fr, col0 = u.pn * 128 + wc * 32 + 8 * fq;
#pragma unroll
        for (int ai = 0; ai < 2; ++ai)
#pragma unroll
            for (int m = 0; m < 4; ++m) {
                const f32x4 g0 = acc[ai][0][m][0], g1 = acc[ai][0][m][1], u0 = acc[ai][1][m][0], u1 = acc[ai][1][m][1];
                u32x4 w;
                w.x = pk2(silu_mul(g0[0], u0[0]), silu_mul(g0[1], u0[1])); w.y = pk2(silu_mul(g0[2], u0[2]), silu_mul(g0[3], u0[3]));
                w.z = pk2(silu_mul(g1[0], u1[0]), silu_mul(g1[1], u1[1])); w.w = pk2(silu_mul(g1[2], u1[2]), silu_mul(g1[3], u1[3]));
                *(u32x4*)(O + (size_t)(row0 + ai * HALF + m * 16) * DFF + col0) = w;
            }
    }
};

struct EpiBf16 {
    static constexpr bool PERM = true, TRANS = true;
    bf16_t* O; int ldc;
    DI void operator()(const f32x4 (&acc)[2][2][4][2], const Unit& u, int wr, int wc, int fr, int fq) const {
        const int row0 = u.pm * BM + wr * 64 + fr, col0 = u.pn * BM + wc * 32 + 8 * fq;
#pragma unroll
        for (int ai = 0; ai < 2; ++ai)
#pragma unroll
            for (int m = 0; m < 4; ++m) {
                bf16_t* rowp = O + (size_t)(row0 + ai * HALF + m * 16) * ldc + col0;
#pragma unroll
                for (int bj = 0; bj < 2; ++bj) { const f32x4 v0 = acc[ai][bj][m][0], v1 = acc[ai][bj][m][1];
                    u32x4 w; w.x = pk2(v0[0], v0[1]); w.y = pk2(v0[2], v0[3]); w.z = pk2(v1[0], v1[1]); w.w = pk2(v1[2], v1[3]);
                    *(u32x4*)(rowp + bj * HALF) = w; }
            }
    }
};

struct EpiMix {
    static constexpr bool PERM = true, TRANS = true;
    bf16_t* Q; bf16_t* Kd; float* MLQK; bf16_t* MLO;
    DI void operator()(const f32x4 (&acc)[2][2][4][2], const Unit& u, int wr, int wc, int fr, int fq) const {
        const int row0 = u.pm * BM + wr * 64 + fr; const int pn = u.pn;
        if (pn < 4) {
            bf16_t* dst = (pn < 2) ? Q : Kd; const float sc = (pn < 2) ? QSCALE : 1.f;
            const int G = (pn & 1) * 4 + wc, head = G >> 1, c = G & 1;
            float ifr[8];
#pragma unroll
            for (int j = 0; j < 8; ++j) ifr[j] = __builtin_amdgcn_exp2f(-(float)(2 * (8 * fq + j)) * (13.287712379549449f / 64.f));
#pragma unroll
            for (int ai = 0; ai < 2; ++ai)
#pragma unroll
                for (int m = 0; m < 4; ++m) {
                    const int row = row0 + ai * HALF + m * 16, b = row >> 13, s = row & (SEQ - 1);
                    const float sf = (float)s;
                    float cs[8], sn[8];
#pragma unroll
                    for (int j = 0; j < 8; ++j) { float rev = (sf * ifr[j]) * 0.15915494309189535f; rev = __builtin_amdgcn_fractf(rev); cs[j] = __builtin_amdgcn_cosf(rev); sn[j] = __builtin_amdgcn_sinf(rev); }
                    const f32x4 r0 = {cs[0], sn[0], cs[1], sn[1]}, r1 = {cs[2], sn[2], cs[3], sn[3]}, r2 = {cs[4], sn[4], cs[5], sn[5]}, r3 = {cs[6], sn[6], cs[7], sn[7]};
                    const f32x4 a0 = acc[ai][0][m][0], a1 = acc[ai][0][m][1], b0 = acc[ai][1][m][0], b1 = acc[ai][1][m][1];
                    u32x4 w1, w2;
                    w1.x = pk2((a0[0] * r0[0] - b0[0] * r0[1]) * sc, (a0[1] * r0[2] - b0[1] * r0[3]) * sc);
                    w1.y = pk2((a0[2] * r1[0] - b0[2] * r1[1]) * sc, (a0[3] * r1[2] - b0[3] * r1[3]) * sc);
                    w1.z = pk2((a1[0] * r2[0] - b1[0] * r2[1]) * sc, (a1[1] * r2[2] - b1[1] * r2[3]) * sc);
                    w1.w = pk2((a1[2] * r3[0] - b1[2] * r3[1]) * sc, (a1[3] * r3[2] - b1[3] * r3[3]) * sc);
                    w2.x = pk2((b0[0] * r0[0] + a0[0] * r0[1]) * sc, (b0[1] * r0[2] + a0[1] * r0[3]) * sc);
                    w2.y = pk2((b0[2] * r1[0] + a0[2] * r1[1]) * sc, (b0[3] * r1[2] + a0[3] * r1[3]) * sc);
                    w2.z = pk2((b1[0] * r2[0] + a1[0] * r2[1]) * sc, (b1[1] * r2[2] + a1[1] * r2[3]) * sc);
                    w2.w = pk2((b1[2] * r3[0] + a1[2] * r3[1]) * sc, (b1[3] * r3[2] + a1[3] * r3[3]) * sc);
                    bf16_t* base = dst + ((size_t)(((b * 4 + head) * 2 + c) * SEQ + s)) * 64 + 8 * fq;
                    *(u32x4*)base = w1; *(u32x4*)(base + 32) = w2;
                }
        } else if (pn < 6) {
            const int col0 = (pn - 4) * BM + wc * 32 + 8 * fq;
#pragma unroll
            for (int ai = 0; ai < 2; ++ai)
#pragma unroll
                for (int m = 0; m < 4; ++m) {
                    float* rowp = MLQK + (size_t)(row0 + ai * HALF + m * 16) * 512 + col0;
#pragma unroll
                    for (int bj = 0; bj < 2; ++bj) { *(f32x4*)(rowp + bj * HALF) = acc[ai][bj][m][0]; *(f32x4*)(rowp + bj * HALF + 4) = acc[ai][bj][m][1]; }
                }
        } else {
            const int col0 = (pn - 6) * BM + wc * 32 + 8 * fq;
#pragma unroll
            for (int ai = 0; ai < 2; ++ai)
#pragma unroll
                for (int m = 0; m < 4; ++m) {
                    bf16_t* rowp = MLO + (size_t)(row0 + ai * HALF + m * 16) * 512 + col0;
#pragma unroll
                    for (int bj = 0; bj < 2; ++bj) { const f32x4 v0 = acc[ai][bj][m][0], v1 = acc[ai][bj][m][1];
                        u32x4 w; w.x = pk2(v0[0], v0[1]); w.y = pk2(v0[2], v0[3]); w.z = pk2(v1[0], v1[1]); w.w = pk2(v1[2], v1[3]);
                        *(u32x4*)(rowp + bj * HALF) = w; }
                }
        }
    }
};

struct EpiVT {
    static constexpr bool PERM = false, TRANS = false;
    bf16_t* VTda; bf16_t* VTml;
    DI void operator()(const f32x4 (&acc)[2][2][4][2], const Unit& u, int wr, int wc, int fr, int fq) const {
        bf16_t* dst = (u.pn < 2) ? VTda : VTml;
#pragma unroll
        for (int ai = 0; ai < 2; ++ai)
#pragma unroll
            for (int m = 0; m < 4; ++m) {
                const int row = u.pm * BM + ai * HALF + wr * 64 + m * 16 + 4 * fq, b = row >> 13, s = row & (SEQ - 1);
#pragma unroll
                for (int bj = 0; bj < 2; ++bj)
#pragma unroll
                    for (int n = 0; n < 2; ++n) {
                        const int head = (u.pn & 1) * 2 + bj, d = wc * 32 + n * 16 + fr;
                        const f32x4 v = acc[ai][bj][m][n];
                        u32x2 w; w.x = pk2(v[0], v[1]); w.y = pk2(v[2], v[3]);
                        *(u32x2*)(dst + ((size_t)((b * 4 + head) * 128 + d)) * SEQ + s) = w;
                    }
            }
    }
};
}

struct Args { const float* in[12]; float* out; unsigned char* ws; int ph_lo, ph_hi; };

struct Ctx {
    LAS unsigned char* lds;
    int tid, lane, wave, bid, G;
    const float *x, *ffn_w_in, *ffn_w_out, *norm_g, *mix_w_in, *mix_w_out, *da_lambda, *da_subln_g, *conv_w, *conv_b, *gate_b, *ml_norm_g;
    float* out; unsigned char* ws;
};

DI void transpose_item(const float* W, int N, int K, int k0, int src_n0, bf16_t* WT, int dst_row0, LAS float* scr, int lane) {
    const int kr = lane >> 3, n4 = (lane & 7) * 4;
    f32x4 v[8];
#pragma unroll
    for (int i = 0; i < 8; ++i) v[i] = *(const f32x4*)(W + (size_t)(k0 + kr + 8 * i) * N + src_n0 + n4);
#pragma unroll
    for (int i = 0; i < 8; ++i) { LAS float* p = scr + (kr + 8 * i) * 33 + n4; p[0] = v[i][0]; p[1] = v[i][1]; p[2] = v[i][2]; p[3] = v[i][3]; }
    asm volatile("s_waitcnt lgkmcnt(0)" ::: "memory");
    const int c = lane & 7;
#pragma unroll
    for (int j = 0; j < 4; ++j) { const int n = (lane >> 3) + 8 * j; const LAS float* s = scr + (8 * c) * 33 + n;
        u32x4 o; o.x = pk2(s[0 * 33], s[1 * 33]); o.y = pk2(s[2 * 33], s[3 * 33]); o.z = pk2(s[4 * 33], s[5 * 33]); o.w = pk2(s[6 * 33], s[7 * 33]);
        *(u32x4*)(WT + (size_t)(dst_row0 + n) * K + k0 + 8 * c) = o; }
    asm volatile("s_waitcnt lgkmcnt(0)" ::: "memory");
}

DI void norm_phase(const Ctx& F, const float* xsrc, float* xdst, const bf16_t* Y, const float* gpost, float coef, const float* gpre, bf16_t* XN,
                   const float* Wg, const float* gate_b, float* gates) {
    LAS float* wgT = (LAS float*)F.lds;
    if (Wg) {
        for (int i = F.tid; i < 1024 * 8; i += NTHREADS) wgT[(i & 7) * 1024 + (i >> 3)] = Wg[(size_t)(i >> 3) * MIXN + (i & 7)];
        __syncthreads();
    }
    const int gw = F.bid * 8 + F.wave, NGW = F.G * 8, lane = F.lane;
    f32x4 gpo[4], gpr[4];
#pragma unroll
    for (int j = 0; j < 4; ++j) { gpo[j] = Y ? ((const f32x4*)gpost)[64 * j + lane] * coef : (f32x4){0.f, 0.f, 0.f, 0.f}; gpr[j] = gpre ? ((const f32x4*)gpre)[64 * j + lane] : (f32x4){0.f, 0.f, 0.f, 0.f}; }
    f32x4 gb0 = {0.f, 0.f, 0.f, 0.f}, gb1 = {0.f, 0.f, 0.f, 0.f};
    if (Wg) { gb0 = *(const f32x4*)gate_b; gb1 = *(const f32x4*)(gate_b + 4); }
    constexpr int NR = 2;
    for (int row0 = gw; row0 < M; row0 += NGW * NR) {
        f32x4 v[NR][4]; u32x2 y[NR][4];
#pragma unroll
        for (int r = 0; r < NR; ++r) {
            const int row = row0 + NGW * r, rowc = row < M ? row : row0;
            const f32x4* xr = (const f32x4*)(xsrc + (size_t)rowc * D) + lane;
#pragma unroll
            for (int j = 0; j < 4; ++j) v[r][j] = __builtin_nontemporal_load(xr + 64 * j);
            if (Y) { const u32x2* yr = (const u32x2*)(Y + (size_t)rowc * D) + lane;
#pragma unroll
                for (int j = 0; j < 4; ++j) y[r][j] = __builtin_nontemporal_load(yr + 64 * j); }
            else {
#pragma unroll
                for (int j = 0; j < 4; ++j) y[r][j] = (u32x2){0u, 0u}; }
        }
#pragma unroll
        for (int r = 0; r < NR; ++r) {
            const int row = row0 + NGW * r;
            if (row < M) {
                if (Y) {
                    f32x4 yf[4]; float s = 0.f;
#pragma unroll
                    for (int j = 0; j < 4; ++j) { yf[j] = (f32x4){bf_lo(y[r][j].x), bf_hi(y[r][j].x), bf_lo(y[r][j].y), bf_hi(y[r][j].y)}; s += (yf[j][0] * yf[j][0] + yf[j][1] * yf[j][1]) + (yf[j][2] * yf[j][2] + yf[j][3] * yf[j][3]); }
                    const float rstd = 1.f / sqrtf(wave_sum_dpp(s) * (1.f / D) + EPS);
                    f32x4* xo = (f32x4*)(xdst + (size_t)row * D) + lane;
#pragma unroll
                    for (int j = 0; j < 4; ++j) { v[r][j] = v[r][j] + yf[j] * gpo[j] * rstd; xo[64 * j] = v[r][j]; }
                }
                if (gpre) {
                    float s = 0.f;
#pragma unroll
                    for (int j = 0; j < 4; ++j) s += (v[r][j][0] * v[r][j][0] + v[r][j][1] * v[r][j][1]) + (v[r][j][2] * v[r][j][2] + v[r][j][3] * v[r][j][3]);
                    const float rstd = 1.f / sqrtf(wave_sum_dpp(s) * (1.f / D) + EPS);
                    u32x2* o8 = (u32x2*)(XN + (size_t)row * D) + lane;
#pragma unroll
                    for (int j = 0; j < 4; ++j) { v[r][j] = v[r][j] * gpr[j] * rstd; u32x2 w; w.x = pk2(v[r][j][0], v[r][j][1]); w.y = pk2(v[r][j][2], v[r][j][3]); o8[64 * j] = w; }
                    if (Wg) {
                        float ga[8];
#pragma unroll
                        for (int g = 0; g < 8; ++g) {
                            float a = 0.f;
#pragma unroll
                            for (int j = 0; j < 4; ++j) { const f32x4 w4 = *(const LAS f32x4*)(wgT + g * 1024 + 256 * j + 4 * lane); a += (w4[0] * v[r][j][0] + w4[1] * v[r][j][1]) + (w4[2] * v[r][j][2] + w4[3] * v[r][j][3]); }
                            ga[g] = wave_sum_dpp(a);
                        }
                        if (lane == 0) {
                            f32x4 o0 = {ga[0] + gb0[0], ga[1] + gb0[1], ga[2] + gb0[2], ga[3] + gb0[3]}, o1 = {ga[4] + gb1[0], ga[5] + gb1[1], ga[6] + gb1[2], ga[7] + gb1[3]};
                            *(f32x4*)(gates + (size_t)row * 8) = o0; *(f32x4*)(gates + (size_t)row * 8 + 4) = o1;
                        }
                    }
                }
            }
        }
    }
    if (Wg) __syncthreads();
}

constexpr int I_IN = 16 * 176, I_OUT = 44 * 32, I_MI = 16 * 96, I_MO = 16 * 32;
DI void conv_one(const Ctx& F, int type, int mi, int r, LAS float* scr) {
    const int lane = F.lane;
    if (type == 0) {
        const int kb = r / 176, nb = r % 176, np = 32 * nb, pn = np >> 8, j = np & 255, bj = j >> 7, jj = j & 127;
        transpose_item(F.ffn_w_in + (size_t)mi * D * 2 * DFF, 2 * DFF, D, 64 * kb, bj * DFF + 128 * pn + jj, (bf16_t*)(F.ws + WS_WIN) + (size_t)mi * 2 * DFF * D, np, scr, lane);
    } else if (type == 1) {
        const int kb = r / 32, nb = r % 32;
        transpose_item(F.ffn_w_out + (size_t)mi * DFF * D, D, DFF, 64 * kb, 32 * nb, (bf16_t*)(F.ws + WS_WOUT) + (size_t)mi * D * DFF, 32 * nb, scr, lane);
    } else if (type == 2) {
        const int kb = r / 96, nb = r % 96, np = 32 * nb, region = np >> 9, off = np & 511;
        int src;
        if (region < 2) { const int j = np & 255, bj = j >> 7, jj = j & 127, grp = jj >> 5; src = (np - j) + grp * 64 + bj * 32; }
        else if (region == 2) src = 1536 + off;
        else if (region == 3) src = 2560 + off;
        else if (region == 4) src = 1024 + off;
        else src = 2048 + off;
        transpose_item(F.mix_w_in + (size_t)mi * D * MIXN, MIXN, D, 64 * kb, src, (bf16_t*)(F.ws + WS_WMIXIN) + (size_t)mi * 3072 * D, np, scr, lane);
    } else {
        const int kb = r / 32, nb = r % 32;
        transpose_item(F.mix_w_out + (size_t)mi * D * D, D, D, 64 * kb, 32 * nb, (bf16_t*)(F.ws + WS_WMIXOUT) + (size_t)mi * D * D, 32 * nb, scr, lane);
    }
}
template <int GRP> DI void conv_group(const Ctx& F, int worker, int nworkers, LAS float* scr) {
    constexpr int NSEG = GRP == 0 ? 2 : (GRP == 3 ? 2 : 4);
    constexpr int types[4][4] = {{0, 1, 0, 0}, {2, 3, 0, 1}, {0, 1, 2, 3}, {0, 1, 0, 0}};
    constexpr int idxs[4][4] = {{0, 0, 0, 0}, {0, 0, 1, 1}, {2, 2, 1, 1}, {3, 3, 0, 0}};
    constexpr int cnt[4] = {I_IN, I_OUT, I_MI, I_MO};
    int total = 0;
#pragma unroll
    for (int sg = 0; sg < NSEG; ++sg) total += cnt[types[GRP][sg]];
    for (int it = worker; it < total; it += nworkers) {
        int r = it;
#pragma unroll
        for (int sg = 0; sg < NSEG; ++sg) {
            const int n = cnt[types[GRP][sg]];
            if (r >= 0 && r < n) conv_one(F, types[GRP][sg], idxs[GRP][sg], r, scr);
            r -= n;
        }
    }
}

DI void prologue(const Ctx& F) {
    LAS float* scr = (LAS float*)(F.lds + F.wave * 16384);
    const int gw = F.bid * 8 + F.wave, NGW = F.G * 8, lane = F.lane;
    conv_group<0>(F, gw, NGW, scr);
    norm_phase(F, F.x, nullptr, nullptr, nullptr, 0.f, F.norm_g, (bf16_t*)(F.ws + WS_XN), nullptr, nullptr, nullptr);
}

DI float silu_f(float v) { return v / (1.f + __expf(-v)); }
DI bf16x8 ld_bf16x8_g(const bf16_t* p) { return *(const bf16x8*)p; }

DI void m1_phase(const Ctx& F, int l) {
    const int tid = F.tid, lane = F.lane, wave = F.wave;
    LAS bf16_t* KW = (LAS bf16_t*)F.lds;
    LAS float* wl = (LAS float*)(F.lds + 9216);
    const float* MLQK = (const float*)(F.ws + WS_MLQK);
    const float* gates = (const float*)(F.ws + WS_GATES);
    const bf16_t* VT = (const bf16_t*)(F.ws + WS_VTML);
    float* UHAT = (float*)(F.ws + WS_UHAT); float* NHAT = (float*)(F.ws + WS_NHAT);
    float* BCUM = (float*)(F.ws + WS_BCUM); float* LOGI = (float*)(F.ws + WS_LOGI);
    float* CHS = (float*)(F.ws + WS_CHS);
    bf16_t* QC = (bf16_t*)(F.ws + WS_QC); bf16_t* KC = (bf16_t*)(F.ws + WS_KC);
    LAS float* cw = (LAS float*)(F.lds + 16384); LAS float* cb = cw + 2048;
    for (int i = tid; i < 2560; i += NTHREADS) cw[i] = (i < 2048) ? F.conv_w[(size_t)l * 2048 + i] : F.conv_b[(size_t)l * 512 + (i - 2048)];
    __syncthreads();
    const int tl = tid >> 3, d0 = (tid & 7) * 8, r = lane & 31, hh = lane >> 5;
    float gi = 0.f, gf = 0.f; f32x4 xin[2][4][2];
#define M1_ISSUE(U) do { const int bh_ = (U) & 7, c_ = (U) >> 3, b_ = bh_ >> 2, h_ = bh_ & 3, s0_ = c_ * 64, tok0_ = b_ * SEQ + s0_; \
        gi = gates[(size_t)(tok0_ + lane) * 8 + h_]; gf = gates[(size_t)(tok0_ + lane) * 8 + 4 + h_]; \
        _Pragma("unroll") for (int which = 0; which < 2; ++which) _Pragma("unroll") for (int j = 0; j < 4; ++j) { const int s_ = s0_ + tl - 3 + j; \
            const float* xp = MLQK + (size_t)(b_ * SEQ + (s_ < 0 ? 0 : s_)) * 512 + which * 256 + h_ * 64 + d0; \
            xin[which][j][0] = *(const f32x4*)xp; xin[which][j][1] = *(const f32x4*)(xp + 4); } } while (0)
    if (F.bid < 1024) M1_ISSUE(F.bid);
    for (int unit = F.bid; unit < 1024; unit += F.G) {
        const int bh = unit & 7, c = unit >> 3, b = bh >> 2, h = bh & 3, s0 = c * 64, tok0 = b * SEQ + s0;
        bf16x8 vfr[4];
        { const bf16_t* ap = VT + ((size_t)(bh * 128 + 32 * (wave >> 1) + r)) * SEQ + s0 + 8 * hh;
#pragma unroll
          for (int ks = 0; ks < 4; ++ks) vfr[ks] = *(const bf16x8*)(ap + 16 * ks); }
        if (wave == 0) {
            const float lf = fminf(gf, 0.f) - log1pf(__expf(-fabsf(gf)));
            float bc = lf;
#pragma unroll
            for (int o = 1; o < 64; o <<= 1) { const float t = shfl_from(bc, (lane - o) & 63); if (lane >= o) bc += t; }
            const float bl = shfl_from(bc, 63);
            const float a = bl - bc + gi;
            const float amax = wave_max_dpp(a);
            wl[lane] = __expf(a - amax);
            BCUM[bh * SEQ + s0 + lane] = bc; LOGI[bh * SEQ + s0 + lane] = gi;
            if (lane == 0) { CHS[bh * 128 + c] = bl; CHS[1024 + bh * 128 + c] = amax; }
        }
        float kv[8];
#pragma unroll
        for (int which = 0; which < 2; ++which) {
            const int ch = which * 256 + h * 64 + d0;
            float a8[8];
            { const f32x4 b0 = *(const LAS f32x4*)(cb + ch), b1 = *(const LAS f32x4*)(cb + ch + 4);
              a8[0] = b0[0]; a8[1] = b0[1]; a8[2] = b0[2]; a8[3] = b0[3]; a8[4] = b1[0]; a8[5] = b1[1]; a8[6] = b1[2]; a8[7] = b1[3]; }
#pragma unroll
            for (int j = 0; j < 4; ++j) {
                const float keep = (s0 + tl - 3 + j >= 0) ? 1.f : 0.f;
                const f32x4 x0 = xin[which][j][0], x1 = xin[which][j][1];
                const f32x4 w0 = *(const LAS f32x4*)(cw + j * 512 + ch) * keep, w1 = *(const LAS f32x4*)(cw + j * 512 + ch + 4) * keep;
                a8[0] += w0[0] * x0[0]; a8[1] += w0[1] * x0[1]; a8[2] += w0[2] * x0[2]; a8[3] += w0[3] * x0[3];
                a8[4] += w1[0] * x1[0]; a8[5] += w1[1] * x1[1]; a8[6] += w1[2] * x1[2]; a8[7] += w1[3] * x1[3];
            }
            const float sc = which == 0 ? 0.125f : 1.f;
#pragma unroll
            for (int i = 0; i < 8; ++i) a8[i] = silu_f(a8[i]) * sc;
            u32x4 w; w.x = pk2(a8[0], a8[1]); w.y = pk2(a8[2], a8[3]); w.z = pk2(a8[4], a8[5]); w.w = pk2(a8[6], a8[7]);
            bf16_t* dst = (which == 0 ? QC : KC) + ((size_t)bh * SEQ + s0 + tl) * 64 + d0;
            *(u32x4*)dst = w;
            if (which == 1) {
#pragma unroll
                for (int i = 0; i < 8; ++i) kv[i] = a8[i];
            }
        }
        if (unit + F.G < 1024) M1_ISSUE(unit + F.G);
        __syncthreads();
        { const float wt = wl[tl];
#pragma unroll
          for (int i = 0; i < 8; ++i) { const unsigned p = pk2(wt * kv[i], 0.f); KW[(d0 + i) * 72 + tl] = (bf16_t)(p & 0xffffu); } }
        __syncthreads();
        { const int et = wave >> 1, dt = wave & 1;
          f32x16 acc;
#pragma unroll
          for (int i = 0; i < 16; ++i) acc[i] = 0.f;
          const LAS bf16_t* bp = KW + (32 * dt + r) * 72 + 8 * hh;
#pragma unroll
          for (int ks = 0; ks < 4; ++ks) { const bf16x8 bb = *(const LAS bf16x8*)(bp + 16 * ks); acc = MFMA32(vfr[ks], bb, acc); }
          float* up = UHAT + ((size_t)(bh * 128 + c) * 128 + 32 * et) * 64 + 32 * dt + r;
#pragma unroll
          for (int i = 0; i < 16; ++i) up[crow(i, hh) * 64] = acc[i];
        }
        if (tid < 64) {
            float s = 0.f;
#pragma unroll
            for (int q8 = 0; q8 < 8; ++q8) { const u32x4 v = *(const LAS u32x4*)(KW + tid * 72 + 8 * q8);
                s += (bf_lo(v.x) + bf_hi(v.x)) + (bf_lo(v.y) + bf_hi(v.y)) + (bf_lo(v.z) + bf_hi(v.z)) + (bf_lo(v.w) + bf_hi(v.w)); }
            NHAT[(size_t)(bh * 128 + c) * 64 + tid] = s;
        }
        __syncthreads();
    }
}

#undef M1_ISSUE
DI void m2_phase(const Ctx& F, int l) {
    const float* UHAT = (const float*)(F.ws + WS_UHAT); const float* NHAT = (const float*)(F.ws + WS_NHAT);
    bf16_t* CPREV = (bf16_t*)(F.ws + WS_CPREV); float* NPREV = (float*)(F.ws + WS_NPREV);
    float* CHS = (float*)(F.ws + WS_CHS);
    LAS float* sco = (LAS float*)F.lds;
    for (int i = F.tid; i < 2048; i += NTHREADS) sco[i] = CHS[i];
    __syncthreads();
    for (int idx = (F.wave * F.G + F.bid) * 64 + F.lane; idx < 8 * 8256; idx += F.G * NTHREADS) {
        const int bh = idx / 8256, e = idx - bh * 8256;
        const float* __restrict__ src; float* __restrict__ dst = nullptr; bf16_t* __restrict__ dst16 = nullptr; int stride;
        if (e < 8192) { src = UHAT + (size_t)bh * 128 * 8192 + e; dst16 = CPREV + (size_t)bh * 128 * 8192 + e; stride = 8192; }
        else { src = NHAT + (size_t)bh * 128 * 64 + (e - 8192); dst = NPREV + (size_t)bh * 128 * 64 + (e - 8192); stride = 64; }
        const LAS float* bl = sco + bh * 128; const LAS float* am = sco + 1024 + bh * 128; float* mp = CHS + 2048 + bh * 128;
        float m = 0.f, C = 0.f;
        for (int c = 0; c < 128; c += 32) {
            float u[32];
#pragma unroll
            for (int i = 0; i < 32; ++i) u[i] = src[(size_t)(c + i) * stride];
#pragma unroll
            for (int i = 0; i < 32; ++i) {
                if (dst16) dst16[(size_t)(c + i) * stride] = (bf16_t)(pk2(C, 0.f) & 0xffffu); else dst[(size_t)(c + i) * stride] = C;
                if (e == 0) mp[c + i] = m;
                const float blc = bl[c + i], amc = am[c + i];
                const float mn = fmaxf(blc + m, amc);
                C = __expf(blc + m - mn) * C + __expf(amc - mn) * u[i];
                m = mn;
            }
        }
    }
}

DI void m3_phase(const Ctx& F, int l) {
    int tid = F.tid; asm volatile("" : "+v"(tid));
    const int lane = tid & 63, wave = F.wave;
    LAS unsigned char* L = F.lds;
    LAS bf16_t* Qs = (LAS bf16_t*)(L + 0); LAS bf16_t* Ks = (LAS bf16_t*)(L + 9216); LAS bf16_t* VTs = (LAS bf16_t*)(L + 18432); LAS bf16_t* Cs = (LAS bf16_t*)(L + 36864);
    LAS bf16_t* Ws = (LAS bf16_t*)(L + 55296); LAS bf16_t* Qds = (LAS bf16_t*)(L + 64512); LAS float* Hs = (LAS float*)(L + 73728);
    LAS float* vu = (LAS float*)(L + 107520); LAS float* vmm = vu + 64; LAS float* vdec = vu + 128; LAS float* vem = vu + 192; LAS float* vnp = vu + 256; LAS float* vhd = vu + 320;
    const bf16_t* QC = (const bf16_t*)(F.ws + WS_QC); const bf16_t* KC = (const bf16_t*)(F.ws + WS_KC);
    const bf16_t* VT = (const bf16_t*)(F.ws + WS_VTML); const bf16_t* MLO = (const bf16_t*)(F.ws + WS_MLO);
    const bf16_t* CPREV = (const bf16_t*)(F.ws + WS_CPREV); const float* NPREV = (const float*)(F.ws + WS_NPREV);
    const float* BCUM = (const float*)(F.ws + WS_BCUM); const float* LOGI = (const float*)(F.ws + WS_LOGI); const float* CHS = (const float*)(F.ws + WS_CHS);
    bf16_t* YMIX = (bf16_t*)(F.ws + WS_XN);
    LAS float* ng = vu + 384;
    if (tid < 128) ng[tid] = F.ml_norm_g[(size_t)l * 128 + tid];
    __syncthreads();
    const int tl = tid >> 3, d0 = (tid & 7) * 8, r = lane & 31, hh = lane >> 5;
    u32x4 gq, gk, gv[2], gc[2]; float bs = 0.f, li = 0.f, mprev = 0.f, npv = 0.f;
#define M3_ISSUE(U) do { const int bh_ = (U) & 7, c_ = (U) >> 3, s0_ = c_ * 64; \
        gq = *(const u32x4*)(QC + ((size_t)bh_ * SEQ + s0_ + tl) * 64 + d0); gk = *(const u32x4*)(KC + ((size_t)bh_ * SEQ + s0_ + tl) * 64 + d0); \
        _Pragma("unroll") for (int i = 0; i < 2; ++i) { const int idx = tid + NTHREADS * i, e = idx >> 3, ch = idx & 7; \
            gv[i] = *(const u32x4*)(VT + ((size_t)(bh_ * 128 + e)) * SEQ + s0_ + ch * 8); \
            gc[i] = *(const u32x4*)(CPREV + ((size_t)(bh_ * 128 + c_) * 128 + e) * 64 + ch * 8); } \
        bs = BCUM[bh_ * SEQ + s0_ + lane]; li = LOGI[bh_ * SEQ + s0_ + lane]; mprev = CHS[2048 + bh_ * 128 + c_]; \
        npv = NPREV[(size_t)(bh_ * 128 + c_) * 64 + lane]; } while (0)
    if (F.bid < 1024) M3_ISSUE(F.bid);
    for (int unit = F.bid; unit < 1024; unit += F.G) {
        const int bh = unit & 7, c = unit >> 3, b = bh >> 2, h = bh & 3, s0 = c * 64, tok0 = b * SEQ + s0;
        const bf16_t* op = MLO + (size_t)(tok0 + tl) * 512 + h * 128 + (tid & 7) * 16;
        const u32x4 o0 = *(const u32x4*)op, o1 = *(const u32x4*)(op + 8);
        *(LAS u32x4*)(Qs + tl * 72 + d0) = gq; *(LAS u32x4*)(Ks + tl * 72 + d0) = gk;
#pragma unroll
        for (int i = 0; i < 2; ++i) {
            const int idx = tid + NTHREADS * i, e = idx >> 3, ch = idx & 7;
            *(LAS u32x4*)(VTs + e * 72 + ch * 8) = gv[i]; *(LAS u32x4*)(Cs + e * 72 + ch * 8) = gc[i];
        }
        if (wave == 0) {
            const float u = li - bs;
            float pm = u;
#pragma unroll
            for (int o = 1; o < 64; o <<= 1) { const float t = shfl_from(pm, (lane - o) & 63); if (lane >= o) pm = fmaxf(pm, t); }
            const float mm = fmaxf(mprev, pm);
            vu[lane] = u; vmm[lane] = mm; vdec[lane] = __expf(mprev - mm); vem[lane] = __expf(-(bs + mm));
        } else if (wave == 1) {
            vnp[lane] = npv;
        }
        if (unit + F.G < 1024) M3_ISSUE(unit + F.G);
        __syncthreads();
        { const u32x4 q = *(const LAS u32x4*)(Qs + tl * 72 + d0); const float dc = vdec[tl];
          u32x4 w; w.x = pk2(bf_lo(q.x) * dc, bf_hi(q.x) * dc); w.y = pk2(bf_lo(q.y) * dc, bf_hi(q.y) * dc); w.z = pk2(bf_lo(q.z) * dc, bf_hi(q.z) * dc); w.w = pk2(bf_lo(q.w) * dc, bf_hi(q.w) * dc);
          *(LAS u32x4*)(Qds + tl * 72 + d0) = w; }
        if (wave < 4) {
            const int jt = wave >> 1, st = wave & 1;
            f32x16 acc;
#pragma unroll
            for (int i = 0; i < 16; ++i) acc[i] = 0.f;
            const LAS bf16_t* ap = Qs + (32 * jt + r) * 72 + 8 * hh; const LAS bf16_t* bp = Ks + (32 * st + r) * 72 + 8 * hh;
#pragma unroll
            for (int ks = 0; ks < 4; ++ks) acc = MFMA32(*(const LAS bf16x8*)(ap + 16 * ks), *(const LAS bf16x8*)(bp + 16 * ks), acc);
            const int s = 32 * st + r; const float us = vu[s];
#pragma unroll
            for (int i = 0; i < 16; ++i) {
                const int j = 32 * jt + crow(i, hh);
                const float val = (s <= j) ? __expf(us - vmm[j]) * acc[i] : 0.f;
                Ws[j * 72 + s] = (bf16_t)(pk2(val, 0.f) & 0xffffu);
            }
        }
        __syncthreads();
        { const int jt = wave >> 2, et = wave & 3;
          f32x16 acc;
#pragma unroll
          for (int i = 0; i < 16; ++i) acc[i] = 0.f;
          const LAS bf16_t* a1 = Ws + (32 * jt + r) * 72 + 8 * hh; const LAS bf16_t* b1 = VTs + (32 * et + r) * 72 + 8 * hh;
          const LAS bf16_t* a2 = Qds + (32 * jt + r) * 72 + 8 * hh; const LAS bf16_t* b2 = Cs + (32 * et + r) * 72 + 8 * hh;
#pragma unroll
          for (int ks = 0; ks < 4; ++ks) acc = MFMA32(*(const LAS bf16x8*)(a1 + 16 * ks), *(const LAS bf16x8*)(b1 + 16 * ks), acc);
#pragma unroll
          for (int ks = 0; ks < 4; ++ks) acc = MFMA32(*(const LAS bf16x8*)(a2 + 16 * ks), *(const LAS bf16x8*)(b2 + 16 * ks), acc);
#pragma unroll
          for (int i = 0; i < 16; ++i) Hs[(32 * jt + crow(i, hh)) * 132 + 32 * et + r] = acc[i];
        }
        if (tid < 64) {
            float rs = 0.f, qn = 0.f;
#pragma unroll
            for (int q8 = 0; q8 < 8; ++q8) {
                const u32x4 v = *(const LAS u32x4*)(Ws + tid * 72 + 8 * q8);
                rs += (bf_lo(v.x) + bf_hi(v.x)) + (bf_lo(v.y) + bf_hi(v.y)) + (bf_lo(v.z) + bf_hi(v.z)) + (bf_lo(v.w) + bf_hi(v.w));
                const u32x4 q = *(const LAS u32x4*)(Qds + tid * 72 + 8 * q8);
                const LAS float* np = vnp + 8 * q8;
                qn += bf_lo(q.x) * np[0] + bf_hi(q.x) * np[1] + bf_lo(q.y) * np[2] + bf_hi(q.y) * np[3] + bf_lo(q.z) * np[4] + bf_hi(q.z) * np[5] + bf_lo(q.w) * np[6] + bf_hi(q.w) * np[7];
            }
            const float den = rs + qn;
            vhd[tid] = 1.f / fmaxf(fabsf(den), vem[tid]);
        }
        __syncthreads();
        { const int j = tl, e0 = (tid & 7) * 16; const float hd = vhd[j];
          f32x4 hv[4]; float ss = 0.f;
#pragma unroll
          for (int i = 0; i < 4; ++i) { hv[i] = *(const LAS f32x4*)(Hs + j * 132 + e0 + 4 * i) * hd; ss += (hv[i][0] * hv[i][0] + hv[i][1] * hv[i][1]) + (hv[i][2] * hv[i][2] + hv[i][3] * hv[i][3]); }
          ss += dpp_f(ss, 0); ss += dpp_f(ss, 1); ss += dpp_f(ss, 2);
          const float rstd = 1.f / sqrtf(ss * (1.f / 128.f) + EPS);
          const unsigned ow[8] = {o0.x, o0.y, o0.z, o0.w, o1.x, o1.y, o1.z, o1.w};
          unsigned res[8];
#pragma unroll
          for (int i = 0; i < 4; ++i) {
              const f32x4 g = *(const LAS f32x4*)(ng + e0 + 4 * i);
              const float oa = bf_lo(ow[2 * i]), ob = bf_hi(ow[2 * i]), oc = bf_lo(ow[2 * i + 1]), od = bf_hi(ow[2 * i + 1]);
              const float v0 = hv[i][0] * rstd * g[0] / (1.f + __expf(-oa)), v1 = hv[i][1] * rstd * g[1] / (1.f + __expf(-ob));
              const float v2 = hv[i][2] * rstd * g[2] / (1.f + __expf(-oc)), v3 = hv[i][3] * rstd * g[3] / (1.f + __expf(-od));
              res[2 * i] = pk2(v0, v1); res[2 * i + 1] = pk2(v2, v3);
          }
          bf16_t* yp = YMIX + (size_t)(tok0 + j) * 1024 + 512 + h * 128 + e0;
          u32x4 w0 = {res[0], res[1], res[2], res[3]}, w1 = {res[4], res[5], res[6], res[7]};
          *(u32x4*)yp = w0; *(u32x4*)(yp + 8) = w1;
        }
        __syncthreads();
    }
}

#undef M3_ISSUE
constexpr float AT_THR = 6.f;
constexpr int AT_STAGE = 36864, AT_K1 = 9216, AT_V = 18432, AT_SG_OFF = LDS_BYTES - 2048;
DI void attn_unit(const Ctx& F, int l, int bh, int qb, float lam) {
    const int tid = F.tid, lane = F.lane, wave = F.wave, c = wave >> 2, rg = wave & 3, r = lane & 31, hh = lane >> 5;
    const int b = bh >> 2, h = bh & 3;
    LAS unsigned char* L = F.lds;
    const bf16_t* Qg = (const bf16_t*)(F.ws + WS_Q); const bf16_t* Kg = (const bf16_t*)(F.ws + WS_K); const bf16_t* VTg = (const bf16_t*)(F.ws + WS_VTDA);
    bf16_t* YMIX = (bf16_t*)(F.ws + WS_XN);
    const int q0 = qb * 128 + rg * 32;
    bf16x8 qf[4];
    { const bf16_t* qp = Qg + ((size_t)((bh * 2 + c) * SEQ) + q0 + r) * 64 + 8 * hh;
#pragma unroll
      for (int ks = 0; ks < 4; ++ks) qf[ks] = *(const bf16x8*)(qp + 16 * ks); }
    const int ntile = 2 * qb + 2, my_n = (rg < 2) ? ntile - 1 : ntile;
    const int krow = tid >> 3, kch = tid & 7;
    const bf16_t* k0p = Kg + ((size_t)((bh * 2 + 0) * SEQ) + krow) * 64 + kch * 8;
    const bf16_t* k1p = Kg + ((size_t)((bh * 2 + 1) * SEQ) + krow) * 64 + kch * 8;
    const bf16_t* v0p = VTg + ((size_t)(bh * 128 + krow)) * SEQ + kch * 8;
    const bf16_t* v1p = VTg + ((size_t)(bh * 128 + 64 + krow)) * SEQ + kch * 8;
    const int kdst = krow * 144 + kch * 16;
    u32x4 pk0, pk1, pv0, pv1;
    pk0 = *(const u32x4*)k0p; pk1 = *(const u32x4*)k1p; pv0 = *(const u32x4*)v0p; pv1 = *(const u32x4*)v1p;
    *(LAS u32x4*)(L + kdst) = pk0; *(LAS u32x4*)(L + AT_K1 + kdst) = pk1; *(LAS u32x4*)(L + AT_V + kdst) = pv0; *(LAS u32x4*)(L + AT_V + 64 * 144 + kdst) = pv1;
    if (ntile > 1) { pk0 = *(const u32x4*)(k0p + 64 * 64); pk1 = *(const u32x4*)(k1p + 64 * 64); pv0 = *(const u32x4*)(v0p + 64); pv1 = *(const u32x4*)(v1p + 64); }
    __syncthreads();
    f32x16 o[4];
#pragma unroll
    for (int dt = 0; dt < 4; ++dt)
#pragma unroll
        for (int i = 0; i < 16; ++i) o[dt][i] = 0.f;
    float m_run = -30.f, l_run = 0.f;
    bf16x8 pb[4];
#pragma unroll
    for (int i = 0; i < 4; ++i) pb[i] = (bf16x8){0, 0, 0, 0, 0, 0, 0, 0};
    const int kap = (r & ~12) | ((r & 4) << 1) | ((r & 8) >> 1);
    const int koff = c * AT_K1 + kap * 144 + 16 * hh, voff = AT_V + r * 144 + 16 * hh;
#define AT_STAGE_STEP(tw) do { if ((tw) < ntile) { LAS unsigned char* S2 = L + ((tw) & 1) * AT_STAGE; \
        *(LAS u32x4*)(S2 + kdst) = pk0; *(LAS u32x4*)(S2 + AT_K1 + kdst) = pk1; *(LAS u32x4*)(S2 + AT_V + kdst) = pv0; *(LAS u32x4*)(S2 + AT_V + 64 * 144 + kdst) = pv1; \
        if ((tw) + 1 < ntile) { const size_t ko = (size_t)((tw) + 1) * 64 * 64, vo = (size_t)((tw) + 1) * 64; \
            pk0 = *(const u32x4*)(k0p + ko); pk1 = *(const u32x4*)(k1p + ko); pv0 = *(const u32x4*)(v0p + vo); pv1 = *(const u32x4*)(v1p + vo); } } } while (0)
    if (c == 1) __syncthreads();
    for (int t = 0; t < ntile; ++t) {
        LAS unsigned char* S = L + (t & 1) * AT_STAGE;
        if (c == 1) AT_STAGE_STEP(t + 1);
        {
            f32x16 p0, p1;
            const float ninit = (t < my_n) ? -m_run : -1e30f;
#pragma unroll
            for (int i = 0; i < 16; ++i) { p0[i] = ninit; p1[i] = ninit; }
#pragma unroll
            for (int ks = 0; ks < 4; ++ks) { const bf16x8 ka = *(const LAS bf16x8*)(S + koff + 32 * ks); p0 = MFMA32(ka, qf[ks], p0); }
#pragma unroll
            for (int ks = 0; ks < 4; ++ks) { const bf16x8 kb = *(const LAS bf16x8*)(S + koff + 32 * 144 + 32 * ks); p1 = MFMA32(kb, qf[ks], p1); }
            float mx0 = max3f(p0[0], p0[1], p0[2]);
#pragma unroll
            for (int i = 3; i < 15; i += 2) mx0 = max3f(mx0, p0[i], p0[i + 1]);
            mx0 = fmaxf(mx0, p0[15]);
            float ps = 0.f;
#pragma unroll
            for (int i = 0; i < 16; ++i) { p0[i] = __builtin_amdgcn_exp2f(p0[i]); ps += p0[i]; }
            float mx = max3f(mx0, p1[0], p1[1]);
#pragma unroll
            for (int i = 2; i < 16; i += 2) mx = max3f(mx, p1[i], p1[i + 1]);
            mx = half_max(mx);
            if (__any(mx > AT_THR)) {
                const float delta = fmaxf(mx, 0.f);
                const float alpha = __builtin_amdgcn_exp2f(-delta);
                m_run += delta; l_run *= alpha; ps *= alpha;
#pragma unroll
                for (int i = 0; i < 16; ++i) { p0[i] *= alpha; p1[i] -= delta; }
#pragma unroll
                for (int dt = 0; dt < 4; ++dt)
#pragma unroll
                    for (int i = 0; i < 16; ++i) o[dt][i] *= alpha;
            }
#pragma unroll
            for (int i = 0; i < 16; ++i) { p1[i] = __builtin_amdgcn_exp2f(p1[i]); ps += p1[i]; }
            l_run += ps;
            { u32x4 w;
              w.x = pk2(p0[0], p0[1]); w.y = pk2(p0[2], p0[3]); w.z = pk2(p0[4], p0[5]); w.w = pk2(p0[6], p0[7]); pb[0] = __builtin_bit_cast(bf16x8, w);
              w.x = pk2(p0[8], p0[9]); w.y = pk2(p0[10], p0[11]); w.z = pk2(p0[12], p0[13]); w.w = pk2(p0[14], p0[15]); pb[1] = __builtin_bit_cast(bf16x8, w);
              w.x = pk2(p1[0], p1[1]); w.y = pk2(p1[2], p1[3]); w.z = pk2(p1[4], p1[5]); w.w = pk2(p1[6], p1[7]); pb[2] = __builtin_bit_cast(bf16x8, w);
              w.x = pk2(p1[8], p1[9]); w.y = pk2(p1[10], p1[11]); w.z = pk2(p1[12], p1[13]); w.w = pk2(p1[14], p1[15]); pb[3] = __builtin_bit_cast(bf16x8, w); }
            asm volatile("" : "+v"(pb[0]), "+v"(pb[1]), "+v"(pb[2]), "+v"(pb[3]), "+v"(l_run));
        }
        __syncthreads();
        if (c == 0) AT_STAGE_STEP(t + 1);
#pragma unroll
        for (int st = 0; st < 4; ++st)
#pragma unroll
            for (int dt = 0; dt < 4; ++dt) {
                const bf16x8 va = *(const LAS bf16x8*)(S + voff + dt * 32 * 144 + 32 * st);
                o[dt] = MFMA32(va, pb[st], o[dt]);
            }
        __syncthreads();
    }
    if (c == 0) __syncthreads();
#undef AT_STAGE_STEP
    const float inv = 1.f / half_sum(l_run);
    LAS float* X = (LAS float*)L;
    if (c == 1) {
#pragma unroll
        for (int dt = 0; dt < 4; ++dt)
#pragma unroll
            for (int i = 0; i < 16; ++i) X[(rg * 128 + 32 * dt + crow(i, hh)) * 32 + r] = o[dt][i] * inv;
    }
    __syncthreads();
    if (c == 0) {
        float ss = 0.f;
#pragma unroll
        for (int dt = 0; dt < 4; ++dt)
#pragma unroll
            for (int i = 0; i < 16; ++i) { const float v = o[dt][i] * inv - lam * X[(rg * 128 + 32 * dt + crow(i, hh)) * 32 + r]; o[dt][i] = v; ss += v * v; }
        ss = half_sum(ss);
        const float li = (l == 0) ? 0.2f : 0.35550907f;
        const float rstd = (1.f - li) / sqrtf(ss * (1.f / 128.f) + EPS);
        const LAS float* sg = (const LAS float*)(F.lds + AT_SG_OFF);
        bf16_t* yp = YMIX + (size_t)(b * SEQ + q0 + r) * 1024 + h * 128;
#pragma unroll
        for (int dt = 0; dt < 4; ++dt)
#pragma unroll
            for (int g4 = 0; g4 < 4; ++g4) {
                const int d = 32 * dt + 8 * g4 + 4 * hh;
                const f32x4 g = *(const LAS f32x4*)(sg + d);
                u32x2 w; w.x = pk2(o[dt][4 * g4] * rstd * g[0], o[dt][4 * g4 + 1] * rstd * g[1]); w.y = pk2(o[dt][4 * g4 + 2] * rstd * g[2], o[dt][4 * g4 + 3] * rstd * g[3]);
                *(u32x2*)(yp + d) = w;
            }
    }
    __syncthreads();
}

DI void attn_m3_phase(const Ctx& F, int l) {
    const float* lv = F.da_lambda + (size_t)l * 256;
    const float s1 = wave_sum_dpp(lv[F.lane] * lv[64 + F.lane]), s2 = wave_sum_dpp(lv[128 + F.lane] * lv[192 + F.lane]);
    const float li = (l == 0) ? 0.2f : 0.35550907f;
    const float lam = expf(s1) - expf(s2) + li;
    if (F.tid < 128) ((LAS float*)(F.lds + AT_SG_OFF))[F.tid] = F.da_subln_g[(size_t)l * 128 + F.tid];
    __syncthreads();
    for (int rep = 0; rep < D_AT; ++rep)
    for (int p = F.bid; p < 256; p += F.G) {
        const int bh = p & 7, i = p >> 3;
#if EN_AT
        attn_unit(F, l, bh, 63 - i, lam);
        attn_unit(F, l, bh, i, lam);
#endif
    }
#if EN_M3
    for (int rep = 0; rep < D_M3; ++rep) m3_phase(F, l);
#endif
}


#define XB_TMO      128
#define XB_XCNT(j)  (256  + 64 * (j))
#define XB_XSUB(j)  (1280 + 64 * (j))
#define XB_XGEN(j)  (2304 + 64 * (j))
#define XB_TOP      3328
#define XB_TOPGEN   3392
#define XCD_BAR_WORDS 3456
#define XB_SPIN_CAP (1u << 22)
DI unsigned xb_ld(unsigned* p)              { return __hip_atomic_load(p, __ATOMIC_RELAXED, __HIP_MEMORY_SCOPE_AGENT); }
DI unsigned xb_add(unsigned* p, unsigned v) { return __hip_atomic_fetch_add(p, v, __ATOMIC_RELAXED, __HIP_MEMORY_SCOPE_AGENT); }
DI unsigned xb_xcc_id() { return (unsigned)__builtin_amdgcn_s_getreg((3 << 11) | 20) & 0xFu; }
#define XB_SPIN(cond, bar) do { unsigned _sp = 0; while (cond) { __builtin_amdgcn_s_sleep(1); \
    if ((++_sp & 255u) == 0u) { if (xb_ld(&(bar)[XB_TMO])) break; if (_sp > XB_SPIN_CAP) { atomicAdd(&(bar)[XB_TMO], 1u); break; } } } } while (0)
struct XcdBarrier { unsigned* bar; unsigned x; volatile LAS unsigned* st; };
DI XcdBarrier xcd_barrier_post(unsigned* bar, volatile LAS unsigned* st) {
    XcdBarrier b; b.bar = bar; b.x = xb_xcc_id(); b.st = st;
    if (threadIdx.x == 0) (void)xb_add(&bar[XB_XCNT(b.x)], 1u);
    return b;
}
DI void xcd_barrier_complete(unsigned* bar, unsigned x, unsigned& nloc, unsigned& nx) {
    const unsigned G = gridDim.x * gridDim.y * gridDim.z;
    unsigned sum, cnt, mine, sp = 0u;
    for (;;) {
        sum = 0u; cnt = 0u; mine = 0u;
#pragma unroll
        for (unsigned j = 0; j < 16; ++j) { const unsigned c = xb_ld(&bar[XB_XCNT(j)]); sum += c; cnt += (c > 0u) ? 1u : 0u; mine = (j == x) ? c : mine; }
        if (sum == G) break;
        __builtin_amdgcn_s_sleep(1);
        if ((++sp & 255u) == 0u) { if (xb_ld(&bar[XB_TMO])) break; if (sp > XB_SPIN_CAP) { atomicAdd(&bar[XB_TMO], 1u); break; } }
    }
    nloc = mine > 0u ? mine : 1u; nx = cnt > 0u ? cnt : 1u;
}
DI void xcd_barrier(const XcdBarrier& b) {
    asm volatile("s_waitcnt vmcnt(0)" ::: "memory");
    __syncthreads();
    if (threadIdx.x == 0) {
        unsigned* bar = b.bar;
        __builtin_amdgcn_s_waitcnt(0);
        unsigned nloc = b.st[0], nx = b.st[1];
        if (nloc == 0u) { xcd_barrier_complete(bar, b.x, nloc, nx); b.st[0] = nloc; b.st[1] = nx; }
        const unsigned old = xb_add(&bar[XB_XSUB(b.x)], 1u);
        const unsigned gen = old / nloc;
        if (old + 1u == (gen + 1u) * nloc) {
            __builtin_amdgcn_fence(__ATOMIC_RELEASE, "agent");
            asm volatile("s_waitcnt vmcnt(0)" ::: "memory");
            const unsigned og = xb_add(&bar[XB_TOP], 1u);
            const unsigned tg = og / nx;
            if (og + 1u == (tg + 1u) * nx) xb_add(&bar[XB_TOPGEN], 1u);
            else XB_SPIN(xb_ld(&bar[XB_TOPGEN]) == tg, bar);
            __builtin_amdgcn_fence(__ATOMIC_ACQUIRE, "agent");
            xb_add(&bar[XB_XGEN(b.x)], 1u);
            asm volatile("s_waitcnt vmcnt(0)" ::: "memory");
        } else {
            XB_SPIN(xb_ld(&bar[XB_XGEN(b.x)]) == gen, bar);
            __builtin_amdgcn_fence(__ATOMIC_ACQUIRE, "agent");
            asm volatile("s_waitcnt vmcnt(0)" ::: "memory");
        }
    }
    __syncthreads();
}

__global__ void __launch_bounds__(NTHREADS, 2) fwd_kernel(Args args) {
    extern __shared__ __attribute__((aligned(16))) unsigned char lds_raw[];
    unsigned char* ws = args.ws;
    bf16_t* XN = (bf16_t*)(ws + WS_XN); bf16_t* ACT = (bf16_t*)(ws + WS_A); bf16_t* Y = (bf16_t*)(ws + WS_Y);
    volatile LAS unsigned* bst = (volatile LAS unsigned*)((LAS unsigned char*)lds_raw + LDS_BYTES - 64);
    if (threadIdx.x < 2) bst[threadIdx.x] = 0u;
    __syncthreads();
    XcdBarrier xbar = xcd_barrier_post((unsigned*)(args.ws + WS_BAR), bst);
    int probe_rep = 0;
    for (int ph = args.ph_lo; ph < args.ph_hi; ++ph) {
        Ctx F;
        F.lds = (LAS unsigned char*)lds_raw;
        { int t = threadIdx.x; asm volatile("" : "+v"(t)); F.tid = t; }
        F.lane = F.tid & 63; F.wave = __builtin_amdgcn_readfirstlane(F.tid >> 6);
        { int bb = blockIdx.x; asm volatile("" : "+s"(bb)); F.bid = bb; }
        F.G = gridDim.x;
        F.x = args.in[0]; F.ffn_w_in = args.in[1]; F.ffn_w_out = args.in[2]; F.norm_g = args.in[3]; F.mix_w_in = args.in[4]; F.mix_w_out = args.in[5];
        F.da_lambda = args.in[6]; F.da_subln_g = args.in[7]; F.conv_w = args.in[8]; F.conv_b = args.in[9]; F.gate_b = args.in[10]; F.ml_norm_g = args.in[11];
        F.out = args.out; F.ws = args.ws;
        if (ph == 0) {
#if EN_PRO
            for (int rep = 0; rep < D_PRO; ++rep) prologue(F);
#endif
        } else {
            const int l = (ph - 1) / 12, k = (ph - 1) % 12;
            const float* ng = F.norm_g + (size_t)l * 6 * D;
            if (k == 0 || k == 9) {
                const int s = (k == 0) ? 0 : 1;
                pg8::Gemm g{XN, (const bf16_t*)(ws + WS_WIN) + (size_t)(l * 2 + s) * 2 * DFF * D, M, 2 * DFF, D};
                pg8::StaticOrder S; S.init(M, 2 * DFF, F.G, F.bid);
                pg8::EpiSwiglu E{ACT};
#if EN_G1
                for (int rep = 0; rep < D_G1; ++rep) pg8::gemm_phase<pg8::EpiSwiglu>(F.lds, F.tid, g, S, E);
#endif
                {
                    const int nun = (M / 256) * (2 * DFF / 256), rem = nun % F.G, first = rem ? rem : 0, nidle = F.G - first;
                    if (F.bid >= first) {
                        LAS float* scr = (LAS float*)(F.lds + F.wave * 16384);
                        const int worker = (F.bid - first) * 8 + F.wave, nworkers = nidle * 8;
                        if (l == 0 && k == 0) conv_group<1>(F, worker, nworkers, scr);
                        else if (l == 0 && k == 9) conv_group<2>(F, worker, nworkers, scr);
                        else if (l == 1 && k == 0) conv_group<3>(F, worker, nworkers, scr);
                    }
                }
            } else if (k == 1 || k == 10 || k == 7) {
                pg8::Gemm g;
                if (k == 7) g = pg8::Gemm{XN, (const bf16_t*)(ws + WS_WMIXOUT) + (size_t)l * D * D, M, D, D};
                else g = pg8::Gemm{ACT, (const bf16_t*)(ws + WS_WOUT) + (size_t)(l * 2 + (k == 1 ? 0 : 1)) * D * DFF, M, D, DFF};
                pg8::StaticOrder S; S.init(M, D, F.G, F.bid);
                pg8::EpiBf16 E{Y, D};
#if EN_G2
                for (int rep = 0; rep < D_G2; ++rep) pg8::gemm_phase<pg8::EpiBf16>(F.lds, F.tid, g, S, E);
#endif
            } else if (k == 2 || k == 8 || k == 11) {
                const float* xsrc = (l == 0 && k == 2) ? F.x : F.out;
                const float* gpost = ng + (k == 2 ? 1 : (k == 8 ? 3 : 5)) * D;
                const float coef = (k == 8) ? 1.f : 0.5f;
                const float* gpre = (k == 2) ? ng + 2 * D : (k == 8 ? ng + 4 * D : (l + 1 < NL ? F.norm_g + (size_t)(l + 1) * 6 * D : nullptr));
                const bool wg = (k == 2);
#if EN_N
                norm_phase(F, xsrc, F.out, Y, gpost, coef, gpre, XN, wg ? F.mix_w_in + (size_t)l * D * MIXN + 3072 : nullptr, F.gate_b + l * 8, (float*)(ws + WS_GATES));
#endif
            } else if (k == 3) {
                const bf16_t* Wt = (const bf16_t*)(ws + WS_WMIXIN) + (size_t)l * 3072 * D;
                { pg8::Gemm g{XN, Wt + (size_t)2048 * D, M, 1024, D}; pg8::StaticOrder S; S.init(M, 1024, F.G, F.bid);
                  pg8::EpiVT E{(bf16_t*)(ws + WS_VTDA), (bf16_t*)(ws + WS_VTML)};
#if EN_G3A
                  for (int rep = 0; rep < D_G3; ++rep) pg8::gemm_phase<pg8::EpiVT>(F.lds, F.tid, g, S, E);
#endif
                }
                { pg8::Gemm g{XN, Wt, M, 2048, D}; pg8::StaticOrder S; S.init(M, 2048, F.G, F.bid);
                  pg8::EpiMix E{(bf16_t*)(ws + WS_Q), (bf16_t*)(ws + WS_K), (float*)(ws + WS_MLQK), (bf16_t*)(ws + WS_MLO)};
#if EN_G3B
                  for (int rep = 0; rep < D_G3; ++rep) pg8::gemm_phase<pg8::EpiMix>(F.lds, F.tid, g, S, E);
#endif
                }
            } else if (k == 4) {
#if EN_M1
                for (int rep = 0; rep < D_M1; ++rep) m1_phase(F, l);
#endif
            } else if (k == 5) {
#if EN_M2
                for (int rep = 0; rep < D_M2; ++rep) m2_phase(F, l);
#endif
            } else if (k == 6) {
                attn_m3_phase(F, l);
            }
        }
        if (PROBE_MASK) {
            const int kk = (ph == 0) ? 12 : (ph - 1) % 12;
            if (((PROBE_MASK >> kk) & 1) && !probe_rep) { probe_rep = 1; --ph; } else probe_rep = 0;
        }
        if (ph + 1 < args.ph_hi) {
            if (args.ph_hi > 4096) cg::this_grid().sync();
            else xcd_barrier(xbar);
        }
    }
}

constexpr int NPHASES = 1 + 12 * NL;

extern "C" void kernel_launch(void* const* d_in, const int* in_sizes, int n_in, void* d_out, int out_size, void* d_ws, size_t ws_size, hipStream_t stream) {
    static int grid = 0;
    if (grid == 0) {
        if (n_in != 12 || in_sizes[0] != M * D || out_size != M * D || ws_size < WS_END) {
            fprintf(stderr, "kernel_launch: unexpected shapes: n_in %d in0 %d out %d ws %zu (need %zu)\n", n_in, n_in > 0 ? in_sizes[0] : -1, out_size, ws_size, (size_t)WS_END); grid = -1; return; }
        int dev = 0, cus = 0, per_cu = 0;
        hipGetDevice(&dev);
        hipDeviceGetAttribute(&cus, hipDeviceAttributeMultiprocessorCount, dev);
        if (hipFuncSetAttribute((const void*)fwd_kernel, hipFuncAttributeMaxDynamicSharedMemorySize, LDS_BYTES) != hipSuccess) { fprintf(stderr, "kernel_launch: hipFuncSetAttribute failed\n"); grid = -1; return; }
        if (hipOccupancyMaxActiveBlocksPerMultiprocessor(&per_cu, (const void*)fwd_kernel, NTHREADS, LDS_BYTES) != hipSuccess || per_cu < 1) { fprintf(stderr, "kernel_launch: occupancy query says %d\n", per_cu); per_cu = 1; }
        (void)hipGetLastError();
        grid = cus * 1;
        if (grid <= 0) grid = 256;
    }
    if (grid < 0) return;
    if (hipMemsetAsync((char*)d_ws + WS_BAR, 0, 16384, stream) != hipSuccess) { fprintf(stderr, "kernel_launch: memset failed\n"); return; }
    Args a{};
    for (int i = 0; i < 12; ++i) a.in[i] = (const float*)d_in[i];
    a.out = (float*)d_out; a.ws = (unsigned char*)d_ws;
#if ONE_LAUNCH
    a.ph_lo = 0; a.ph_hi = NPHASES;
    void* kargs[] = {&a};
    hipError_t e = hipLaunchCooperativeKernel((const void*)fwd_kernel, dim3(grid), dim3(NTHREADS), kargs, LDS_BYTES, stream);
    if (e != hipSuccess) fprintf(stderr, "kernel_launch: cooperative launch failed: %s (grid %d)\n", hipGetErrorString(e), grid);
#else
    for (int ph = 0; ph < NPHASES; ++ph) {
        a.ph_lo = ph; a.ph_hi = ph + 1;
        hipLaunchKernelGGL(fwd_kernel, dim3(grid), dim3(NTHREADS), LDS_BYTES, stream, a);
    }
#endif
}
```

```cpp
#include <hip/hip_runtime.h>
#include <hip/hip_cooperative_groups.h>
#include <cstdio>
#include <cstdint>
namespace cg = cooperative_groups;

#ifndef ONE_LAUNCH
#define ONE_LAUNCH 1
#endif

#ifndef D_PRO
#define D_PRO 1
#endif
#ifndef D_G1
#define D_G1 1
#endif
#ifndef D_G2
#define D_G2 1
#endif
#ifndef D_G3
#define D_G3 1
#endif
#ifndef D_M1
#define D_M1 1
#endif
#ifndef D_M2
#define D_M2 1
#endif
#ifndef D_AT
#define D_AT 1
#endif
#ifndef D_M3
#define D_M3 1
#endif
#ifndef PROBE_MASK
#define PROBE_MASK 0
#endif
#ifndef EN_ALL
#define EN_ALL 1
#endif
#ifndef EN_PRO
#define EN_PRO EN_ALL
#endif
#ifndef EN_G1
#define EN_G1 EN_ALL
#endif
#ifndef EN_G2
#define EN_G2 EN_ALL
#endif
#ifndef EN_N
#define EN_N EN_ALL
#endif
#ifndef EN_G3A
#define EN_G3A EN_ALL
#endif
#ifndef EN_G3B
#define EN_G3B EN_ALL
#endif
#ifndef EN_M1
#define EN_M1 EN_ALL
#endif
#ifndef EN_M2
#define EN_M2 EN_ALL
#endif
#ifndef EN_AT
#define EN_AT EN_ALL
#endif
#ifndef EN_M3
#define EN_M3 EN_ALL
#endif
#define LAS __attribute__((address_space(3)))
#define DI __device__ __forceinline__
typedef unsigned short bf16_t;
typedef short bf16x8 __attribute__((ext_vector_type(8)));
typedef float f32x4 __attribute__((ext_vector_type(4)));
typedef float f32x16 __attribute__((ext_vector_type(16)));
typedef unsigned u32x4 __attribute__((ext_vector_type(4)));
typedef unsigned u32x2 __attribute__((ext_vector_type(2)));
typedef __bf16 bf16x2_t __attribute__((ext_vector_type(2)));
typedef float f32x2_t __attribute__((ext_vector_type(2)));

constexpr int NB = 2, SEQ = 8192, M = NB * SEQ, D = 1024, DFF = 2816, NL = 2;
constexpr int MIXN = 3080;
constexpr float EPS = 1e-6f;
constexpr float LOG2E = 1.4426950408889634f;
constexpr float QSCALE = 0.125f * LOG2E;

constexpr size_t MiB = 1u << 20;
constexpr size_t WS_WIN = 0;
constexpr size_t WS_WOUT = 44 * MiB;
constexpr size_t WS_WMIXIN = 66 * MiB;
constexpr size_t WS_WMIXOUT = 78 * MiB;
constexpr size_t WS_GATES = 84 * MiB;
constexpr size_t WS_BCUM = WS_GATES + 512 * 1024;
constexpr size_t WS_LOGI = WS_BCUM + 256 * 1024;
constexpr size_t WS_NHAT = WS_LOGI + 256 * 1024;
constexpr size_t WS_NPREV = WS_NHAT + 256 * 1024;
constexpr size_t WS_CHS = WS_NPREV + 256 * 1024;
constexpr size_t WS_BAR = WS_CHS + 64 * 1024;
constexpr size_t WS_XN = 86 * MiB;
constexpr size_t WS_A = 118 * MiB;
constexpr size_t WS_Q = WS_A, WS_K = WS_A + 16 * MiB, WS_VTDA = WS_A + 32 * MiB, WS_VTML = WS_A + 48 * MiB, WS_MLO = WS_A + 64 * MiB, WS_QC = WS_A + 80 * MiB, WS_KC = WS_A + 88 * MiB;
constexpr size_t WS_Y = 214 * MiB;
constexpr size_t WS_MLQK = WS_Y, WS_CPREV = WS_Y, WS_UHAT = WS_Y + 32 * MiB;
constexpr size_t WS_END = 278 * MiB;

constexpr int LDS_BYTES = 147456;
constexpr int NTHREADS = 512;

DI unsigned pk2(float lo, float hi) { f32x2_t v = {lo, hi}; bf16x2_t b = __builtin_convertvector(v, bf16x2_t); return __builtin_bit_cast(unsigned, b); }
DI float bf_lo(unsigned u) { return __builtin_bit_cast(float, u << 16); }
DI float bf_hi(unsigned u) { return __builtin_bit_cast(float, u & 0xffff0000u); }
DI float dpp_f(float v, const int ctrl_sel) {
    const int x = __builtin_bit_cast(int, v);
    int r;
    if (ctrl_sel == 0) r = __builtin_amdgcn_update_dpp(0, x, 0xB1, 0xF, 0xF, true);
    else if (ctrl_sel == 1) r = __builtin_amdgcn_update_dpp(0, x, 0x4E, 0xF, 0xF, true);
    else if (ctrl_sel == 2) r = __builtin_amdgcn_update_dpp(0, x, 0x141, 0xF, 0xF, true);
    else r = __builtin_amdgcn_update_dpp(0, x, 0x140, 0xF, 0xF, true);
    return __builtin_bit_cast(float, r);
}
DI float wave_sum_dpp(float v) {
    v += dpp_f(v, 0); v += dpp_f(v, 1); v += dpp_f(v, 2); v += dpp_f(v, 3);
    { auto rr = __builtin_amdgcn_permlane16_swap(__builtin_bit_cast(unsigned, v), __builtin_bit_cast(unsigned, v), false, false);
      v = __builtin_bit_cast(float, (unsigned)rr[0]) + __builtin_bit_cast(float, (unsigned)rr[1]); }
    { auto rr = __builtin_amdgcn_permlane32_swap(__builtin_bit_cast(unsigned, v), __builtin_bit_cast(unsigned, v), false, false);
      v = __builtin_bit_cast(float, (unsigned)rr[0]) + __builtin_bit_cast(float, (unsigned)rr[1]); }
    return v;
}
DI float wave_max_dpp(float v) {
    v = fmaxf(v, dpp_f(v, 0)); v = fmaxf(v, dpp_f(v, 1)); v = fmaxf(v, dpp_f(v, 2)); v = fmaxf(v, dpp_f(v, 3));
    { auto rr = __builtin_amdgcn_permlane16_swap(__builtin_bit_cast(unsigned, v), __builtin_bit_cast(unsigned, v), false, false);
      v = fmaxf(__builtin_bit_cast(float, (unsigned)rr[0]), __builtin_bit_cast(float, (unsigned)rr[1])); }
    { auto rr = __builtin_amdgcn_permlane32_swap(__builtin_bit_cast(unsigned, v), __builtin_bit_cast(unsigned, v), false, false);
      v = fmaxf(__builtin_bit_cast(float, (unsigned)rr[0]), __builtin_bit_cast(float, (unsigned)rr[1])); }
    return v;
}
DI float half_sum(float v) { auto rr = __builtin_amdgcn_permlane32_swap(__builtin_bit_cast(unsigned, v), __builtin_bit_cast(unsigned, v), false, false);
    return __builtin_bit_cast(float, (unsigned)rr[0]) + __builtin_bit_cast(float, (unsigned)rr[1]); }
DI float half_max(float v) { auto rr = __builtin_amdgcn_permlane32_swap(__builtin_bit_cast(unsigned, v), __builtin_bit_cast(unsigned, v), false, false);
    return fmaxf(__builtin_bit_cast(float, (unsigned)rr[0]), __builtin_bit_cast(float, (unsigned)rr[1])); }
DI float shfl_from(float v, int src_lane) { return __builtin_bit_cast(float, __builtin_amdgcn_ds_bpermute(src_lane << 2, __builtin_bit_cast(int, v))); }
DI int crow(int reg, int h) { return (reg & 3) + 8 * (reg >> 2) + 4 * h; }
DI float max3f(float a, float b, float c) { float r; asm("v_max3_f32 %0, %1, %2, %3" : "=v"(r) : "v"(a), "v"(b), "v"(c)); return r; }
#define MFMA32(a, b, c) __builtin_amdgcn_mfma_f32_32x32x16_bf16((a), (b), (c), 0, 0, 0)

namespace pg8 {
constexpr int BM = 256, BK = 64, HALF = 128, HTB = HALF * BK * 2, STAGE_BYTES = 8 * HTB, NXCD = 8, WGM = 8;
DI int lds_byte(int r, int c) { const int st = (r >> 4) * 2 + (c >> 5), rr = r & 15, cc = c & 31, ob = rr * 64 + cc * 2; return st * 1024 + (ob ^ (((ob >> 9) & 1) << 5)); }
DI void stage_rc(int b, int& R, int& C) { const int st = b / 1024, sb = b % 1024, swz = sb ^ (((sb >> 9) & 1) << 5); R = (st >> 1) * 16 + swz / 64; C = (st & 1) * 32 + (swz % 64) / 2; }
DI int perm32(int rho) { const int n = rho >> 4, i = rho & 15; return 8 * (i >> 2) + 4 * n + (i & 3); }
struct Unit { int pm, pn; };
struct Gemm { const bf16_t* A; const bf16_t* Bt; int M, N, K; };
struct StaticOrder {
    int nM, nN, nwg, G, c;
    DI void init(int M_, int N_, int G_, int c_) { nM = M_ / BM; nN = N_ / BM; nwg = nM * nN; G = G_; c = c_; }
    DI bool next(int i, Unit& u) const {
        const long L = (long)i * G + c; if (L >= nwg) return false;
        int wgid = (int)L; { const int q = nwg / NXCD, r = nwg % NXCD, xcd = wgid % NXCD, off = wgid / NXCD; wgid = (xcd < r ? xcd * (q + 1) : r * (q + 1) + (xcd - r) * q) + off; }
        const int nig = WGM * nN, gid = wgid / nig, fm = gid * WGM, gsz = (nM - fm) < WGM ? (nM - fm) : WGM;
        u.pm = fm + ((wgid % nig) % gsz); u.pn = (wgid % nig) / gsz; return true;
    }
};

template <class Epi>
DI void gemm_phase(LAS unsigned char* lds, const int tid, const Gemm g, const StaticOrder& S, const Epi& E) {
    const int wid = __builtin_amdgcn_readfirstlane(tid >> 6), lane = tid & 63, wr = wid >> 2, wc = wid & 3, fr = lane & 15, fq = lane >> 4;
    const int K = g.K, nt = K / BK;
    unsigned voffA[2], voffB[2];
#pragma unroll
    for (int i = 0; i < 2; ++i) { int R, C; stage_rc(tid * 16 + i * 8192, R, C); const int Rb = Epi::PERM ? ((R & ~31) + perm32(R & 31)) : R;
        voffA[i] = (unsigned)(R * K + C) * 2u; voffB[i] = (unsigned)(Rb * K + C) * 2u; }
    const size_t kstep = (size_t)(BK * 2);
    const size_t hstep = (size_t)HALF * K * 2;
    const size_t tstep = 2 * hstep;
    const unsigned ldsw = (unsigned)wid * 1024u;
    const int aoff = lds_byte(wr * 64 + fr, fq * 8), boff = lds_byte(wc * 32 + fr, fq * 8);
#define PG8_SA(b, h) (((b) * 2 + (h)) * HTB)
#define PG8_SB(b, h) ((4 + (b) * 2 + (h)) * HTB)
#define PG8_STAGE(bufoff, gbase, voff) do { _Pragma("unroll") for (int _i = 0; _i < 2; ++_i) \
        __builtin_amdgcn_global_load_lds((const unsigned*)((const char*)(gbase) + (voff)[_i]), (LAS unsigned*)(lds + (bufoff) + ldsw + _i * 8192), 16, 0, 0); } while (0)
#define PG8_LDA(dst, b, h) do { _Pragma("unroll") for (int m = 0; m < 4; ++m) _Pragma("unroll") for (int k = 0; k < 2; ++k) dst[m][k] = *(const LAS bf16x8*)(lds + PG8_SA(b, h) + aoff + m * 2048 + k * 1024); } while (0)
#define PG8_LDB(dst, b, h) do { _Pragma("unroll") for (int n = 0; n < 2; ++n) _Pragma("unroll") for (int k = 0; k < 2; ++k) dst[n][k] = *(const LAS bf16x8*)(lds + PG8_SB(b, h) + boff + n * 2048 + k * 1024); } while (0)
#define PG8_MMA(ai, bj, At, Bt) do { __builtin_amdgcn_s_setprio(1); _Pragma("unroll") for (int m = 0; m < 4; ++m) _Pragma("unroll") for (int n = 0; n < 2; ++n) _Pragma("unroll") for (int k = 0; k < 2; ++k) \
        acc[ai][bj][m][n] = Epi::TRANS ? __builtin_amdgcn_mfma_f32_16x16x32_bf16(Bt[n][k], At[m][k], acc[ai][bj][m][n], 0, 0, 0) \
                                       : __builtin_amdgcn_mfma_f32_16x16x32_bf16(At[m][k], Bt[n][k], acc[ai][bj][m][n], 0, 0, 0); __builtin_amdgcn_s_setprio(0); } while (0)
#define PG8_WAIT_V(n) asm volatile("s_waitcnt vmcnt(" #n ")" ::: "memory")
#define PG8_WAIT_L(n) asm volatile("s_waitcnt lgkmcnt(" #n ")" ::: "memory")
#define PG8_BAR __builtin_amdgcn_s_barrier()
#define PG8_SCHED __builtin_amdgcn_sched_barrier(0)
    Unit cur, nxt; int ui = 0;
    if (!S.next(0, cur)) return;
    f32x4 acc[2][2][4][2];
#pragma unroll
    for (int a = 0; a < 2; ++a)
#pragma unroll
        for (int b = 0; b < 2; ++b)
#pragma unroll
            for (int m = 0; m < 4; ++m)
#pragma unroll
                for (int n = 0; n < 2; ++n) acc[a][b][m][n] = (f32x4){0.f, 0.f, 0.f, 0.f};
    bf16x8 At[4][2], B0[2][2], B1[2][2];
    const char* cA = (const char*)g.A + (size_t)cur.pm * tstep; const char* cB = (const char*)g.Bt + (size_t)cur.pn * tstep;
    PG8_STAGE(PG8_SB(0, 0), cB, voffB); PG8_STAGE(PG8_SB(0, 1), cB + hstep, voffB); PG8_STAGE(PG8_SA(0, 0), cA, voffA); PG8_STAGE(PG8_SA(0, 1), cA + hstep, voffA);
    if (wr == 1) PG8_BAR;
    PG8_WAIT_V(2); PG8_BAR;
    PG8_STAGE(PG8_SB(1, 0), cB + kstep, voffB); PG8_STAGE(PG8_SA(1, 0), cA + kstep, voffA); PG8_STAGE(PG8_SB(1, 1), cB + hstep + kstep, voffB);
    PG8_WAIT_V(6); PG8_BAR;
    for (;;) {
        const bool has_next = S.next(ui + 1, nxt);
        const char* nA = has_next ? (const char*)g.A + (size_t)nxt.pm * tstep : cA; const char* nB = has_next ? (const char*)g.Bt + (size_t)nxt.pn * tstep : cB;
        for (int t = 0; t < nt; t += 2) {
            const bool last = (t == nt - 2);
            const char* a1 = cA + (size_t)(t + 1) * kstep;
            const char* a2 = last ? nA : cA + (size_t)(t + 2) * kstep; const char* b2 = last ? nB : cB + (size_t)(t + 2) * kstep;
            const char* a3 = a2 + kstep; const char* b3 = b2 + kstep;
            PG8_LDB(B0, 0, 0); PG8_LDB(B1, 0, 1); PG8_SCHED; PG8_LDA(At, 0, 0); PG8_STAGE(PG8_SA(1, 1), a1 + hstep, voffA);
            PG8_WAIT_V(8); PG8_WAIT_L(0); PG8_BAR; PG8_MMA(0, 0, At, B0); PG8_MMA(0, 1, At, B1); PG8_BAR; PG8_SCHED;
            PG8_LDA(At, 0, 1); PG8_STAGE(PG8_SB(0, 0), b2, voffB); PG8_STAGE(PG8_SB(0, 1), b2 + hstep, voffB); PG8_STAGE(PG8_SA(0, 0), a2, voffA);
            PG8_WAIT_V(8); PG8_WAIT_L(0); PG8_BAR; PG8_MMA(1, 0, At, B0); PG8_MMA(1, 1, At, B1); PG8_BAR; PG8_SCHED;
            PG8_LDB(B0, 1, 0); PG8_LDB(B1, 1, 1); PG8_SCHED; PG8_LDA(At, 1, 0); PG8_STAGE(PG8_SA(0, 1), a2 + hstep, voffA);
            PG8_WAIT_V(8); PG8_WAIT_L(0); PG8_BAR; PG8_MMA(0, 0, At, B0); PG8_MMA(0, 1, At, B1); PG8_BAR; PG8_SCHED;
            PG8_LDA(At, 1, 1); PG8_STAGE(PG8_SB(1, 0), b3, voffB); PG8_STAGE(PG8_SB(1, 1), b3 + hstep, voffB); PG8_STAGE(PG8_SA(1, 0), a3, voffA);
            PG8_WAIT_V(8); PG8_WAIT_L(0); PG8_BAR; PG8_MMA(1, 0, At, B0); PG8_MMA(1, 1, At, B1); PG8_BAR; PG8_SCHED;
        }
        if (wr == 0) PG8_BAR;
        E(acc, cur, wr, wc, fr, fq);
        if (!has_next) break;
#pragma unroll
        for (int a = 0; a < 2; ++a)
#pragma unroll
            for (int b = 0; b < 2; ++b)
#pragma unroll
                for (int m = 0; m < 4; ++m)
#pragma unroll
                    for (int n = 0; n < 2; ++n) acc[a][b][m][n] = (f32x4){0.f, 0.f, 0.f, 0.f};
        cur = nxt; cA = nA; cB = nB; ++ui;
        if (wr == 1) PG8_BAR;
    }
    PG8_WAIT_V(0);
    PG8_BAR;
#undef PG8_SA
#undef PG8_SB
#undef PG8_STAGE
#undef PG8_LDA
#undef PG8_LDB
#undef PG8_MMA
#undef PG8_WAIT_V
#undef PG8_WAIT_L
#undef PG8_BAR
#undef PG8_SCHED
}

DI float silu_mul(float g, float u) { return g * __builtin_amdgcn_rcpf(1.f + __builtin_amdgcn_exp2f(-g * LOG2E)) * u; }

struct EpiSwiglu {
    static constexpr bool PERM = true, TRANS = true;
    bf16_t* O;
    DI void operator()(const f32x4 (&acc)[2][2][4][2], const Unit& u, int wr, int wc, int fr, int fq) const {
        const int row0 = u.pm * BM + wr * 64 + fr, col0 = u.pn * 128 + wc * 32 + 8 * fq;
#pragma unroll
        for (int ai = 0; ai < 2; ++ai)
#pragma unroll
            for (int m = 0; m < 4; ++m) {
                const f32x4 g0 = acc[ai][0][m][0], g1 = acc[ai][0][m][1], u0 = acc[ai][1][m][0], u1 = acc[ai][1][m][1];
                u32x4 w;
                w.x = pk2(silu_mul(g0[0], u0[0]), silu_mul(g0[1], u0[1])); w.y = pk2(silu_mul(g0[2], u0[2]), silu_mul(g0[3], u0[3]));
                w.z = pk2(silu_mul(g1[0], u1[0]), silu_mul(g1[1], u1[1])); w.w = pk2(silu_mul(g1[2], u1[2]), silu_mul(g1[3], u1[3]));
                *(u32x4*)(O + (size_t)(row0 + ai * HALF + m * 16) * DFF + col0) = w;
            }
    }
};

struct EpiBf16 {
    static constexpr bool PERM = true, TRANS = true;
    bf16_t* O; int ldc;
    DI void operator()(const f32x4 (&acc)[2][2][4][2], const Unit& u, int wr, int wc, int fr, int fq) const {
        const int row0 = u.pm * BM + wr * 64 + fr, col0 = u.pn * BM + wc * 32 + 8 * fq;
#pragma unroll
        for (int ai = 0; ai < 2; ++ai)
#pragma unroll
            for (int m = 0; m < 4; ++m) {
                bf16_t* rowp = O + (size_t)(row0 + ai * HALF + m * 16) * ldc + col0;
#pragma unroll
                for (int bj = 0; bj < 2; ++bj) { const f32x4 v0 = acc[ai][bj][m][0], v1 = acc[ai][bj][m][1];
                    u32x4 w; w.x = pk2(v0[0], v0[1]); w.y = pk2(v0[2], v0[3]); w.z = pk2(v1[0], v1[1]); w.w = pk2(v1[2], v1[3]);
                    *(u32x4*)(rowp + bj * HALF) = w; }
            }
    }
};

struct EpiMix {
    static constexpr bool PERM = true, TRANS = true;
    bf16_t* Q; bf16_t* Kd; float* MLQK; bf16_t* MLO;
    DI void operator()(const f32x4 (&acc)[2][2][4][2], const Unit& u, int wr, int wc, int fr, int fq) const {
        const int row0 = u.pm * BM + wr * 64 + fr; const int pn = u.pn;
        if (pn < 4) {
            bf16_t* dst = (pn < 2) ? Q : Kd; const float sc = (pn < 2) ? QSCALE : 1.f;
            const int G = (pn & 1) * 4 + wc, head = G >> 1, c = G & 1;
            float ifr[8];
#pragma unroll
            for (int j = 0; j < 8; ++j) ifr[j] = __builtin_amdgcn_exp2f(-(float)(2 * (8 * fq + j)) * (13.287712379549449f / 64.f));
#pragma unroll
            for (int ai = 0; ai < 2; ++ai)
#pragma unroll
                for (int m = 0; m < 4; ++m) {
                    const int row = row0 + ai * HALF + m * 16, b = row >> 13, s = row & (SEQ - 1);
                    const float sf = (float)s;
                    float cs[8], sn[8];
#pragma unroll
                    for (int j = 0; j < 8; ++j) { float rev = (sf * ifr[j]) * 0.15915494309189535f; rev = __builtin_amdgcn_fractf(rev); cs[j] = __builtin_amdgcn_cosf(rev); sn[j] = __builtin_amdgcn_sinf(rev); }
                    const f32x4 r0 = {cs[0], sn[0], cs[1], sn[1]}, r1 = {cs[2], sn[2], cs[3], sn[3]}, r2 = {cs[4], sn[4], cs[5], sn[5]}, r3 = {cs[6], sn[6], cs[7], sn[7]};
                    const f32x4 a0 = acc[ai][0][m][0], a1 = acc[ai][0][m][1], b0 = acc[ai][1][m][0], b1 = acc[ai][1][m][1];
                    u32x4 w1, w2;
                    w1.x = pk2((a0[0] * r0[0] - b0[0] * r0[1]) * sc, (a0[1] * r0[2] - b0[1] * r0[3]) * sc);
                    w1.y = pk2((a0[2] * r1[0] - b0[2] * r1[1]) * sc, (a0[3] * r1[2] - b0[3] * r1[3]) * sc);
                    w1.z = pk2((a1[0] * r2[0] - b1[0] * r2[1]) * sc, (a1[1] * r2[2] - b1[1] * r2[3]) * sc);
                    w1.w = pk2((a1[2] * r3[0] - b1[2] * r3[1]) * sc, (a1[3] * r3[2] - b1[3] * r3[3]) * sc);
                    w2.x = pk2((b0[0] * r0[0] + a0[0] * r0[1]) * sc, (b0[1] * r0[2] + a0[1] * r0[3]) * sc);
                    w2.y = pk2((b0[2] * r1[0] + a0[2] * r1[1]) * sc, (b0[3] * r1[2] + a0[3] * r1[3]) * sc);
                    w2.z = pk2((b1[0] * r2[0] + a1[0] * r2[1]) * sc, (b1[1] * r2[2] + a1[1] * r2[3]) * sc);
                    w2.w = pk2((b1[2] * r3[0] + a1[2] * r3[1]) * sc, (b1[3] * r3[2] + a1[3] * r3[3]) * sc);
                    bf16_t* base = dst + ((size_t)(((b * 4 + head) * 2 + c) * SEQ + s)) * 64 + 8 * fq;
                    *(u32x4*)base = w1; *(u32x4*)(base + 32) = w2;
                }
        } else if (pn < 6) {
            const int col0 = (pn - 4) * BM + wc * 32 + 8 * fq;
#pragma unroll
            for (int ai = 0; ai < 2; ++ai)
#pragma unroll
                for (int m = 0; m < 4; ++m) {
                    float* rowp = MLQK + (size_t)(row0 + ai * HALF + m * 16) * 512 + col0;
#pragma unroll
                    for (int bj = 0; bj < 2; ++bj) { *(f32x4*)(rowp + bj * HALF) = acc[ai][bj][m][0]; *(f32x4*)(rowp + bj * HALF + 4) = acc[ai][bj][m][1]; }
                }
        } else {
            const int col0 = (pn - 6) * BM + wc * 32 + 8 * fq;
#pragma unroll
            for (int ai = 0; ai < 2; ++ai)
#pragma unroll
                for (int m = 0; m < 4; ++m) {
                    bf16_t* rowp = MLO + (size_t)(row0 + ai * HALF + m * 16) * 512 + col0;
#pragma unroll
                    for (int bj = 0; bj < 2; ++bj) { const f32x4 v0 = acc[ai][bj][m][0], v1 = acc[ai][bj][m][1];
                        u32x4 w; w.x = pk2(v0[0], v0[1]); w.y = pk2(v0[2], v0[3]); w.z = pk2(v1[0], v1[1]); w.w = pk2(v1[2], v1[3]);
                        *(u32x4*)(rowp + bj * HALF) = w; }
                }
        }
    }
};

struct EpiVT {
    static constexpr bool PERM = false, TRANS = false;
    bf16_t* VTda; bf16_t* VTml;
    DI void operator()(const f32x4 (&acc)[2][2][4][2], const Unit& u, int wr, int wc, int fr, int fq) const {
        bf16_t* dst = (u.pn < 2) ? VTda : VTml;
#pragma unroll
        for (int ai = 0; ai < 2; ++ai)
#pragma unroll
            for (int m = 0; m < 4; ++m) {
                const int row = u.pm * BM + ai * HALF + wr * 64 + m * 16 + 4 * fq, b = row >> 13, s = row & (SEQ - 1);
#pragma unroll
                for (int bj = 0; bj < 2; ++bj)
#pragma unroll
                    for (int n = 0; n < 2; ++n) {
                        const int head = (u.pn & 1) * 2 + bj, d = wc * 32 + n * 16 + fr;
                        const f32x4 v = acc[ai][bj][m][n];
                        u32x2 w; w.x = pk2(v[0], v[1]); w.y = pk2(v[2], v[3]);
                        *(u32x2*)(dst + ((size_t)((b * 4 + head) * 128 + d)) * SEQ + s) = w;
                    }
            }
    }
};
}

struct Args { const float* in[12]; float* out; unsigned char* ws; int ph_lo, ph_hi; };

struct Ctx {
    LAS unsigned char* lds;
    int tid, lane, wave, bid, G;
    const float *x, *ffn_w_in, *ffn_w_out, *norm_g, *mix_w_in, *mix_w_out, *da_lambda, *da_subln_g, *conv_w, *conv_b, *gate_b, *ml_norm_g;
    float* out; unsigned char* ws;
};

DI void transpose_item(const float* W, int N, int K, int k0, int src_n0, bf16_t* WT, int dst_row0, LAS float* scr, int lane) {
    const int kr = lane >> 3, n4 = (lane & 7) * 4;
    f32x4 v[8];
#pragma unroll
    for (int i = 0; i < 8; ++i) v[i] = *(const f32x4*)(W + (size_t)(k0 + kr + 8 * i) * N + src_n0 + n4);
#pragma unroll
    for (int i = 0; i < 8; ++i) { LAS float* p = scr + (kr + 8 * i) * 33 + n4; p[0] = v[i][0]; p[1] = v[i][1]; p[2] = v[i][2]; p[3] = v[i][3]; }
    asm volatile("s_waitcnt lgkmcnt(0)" ::: "memory");
    const int c = lane & 7;
#pragma unroll
    for (int j = 0; j < 4; ++j) { const int n = (lane >> 3) + 8 * j; const LAS float* s = scr + (8 * c) * 33 + n;
        u32x4 o; o.x = pk2(s[0 * 33], s[1 * 33]); o.y = pk2(s[2 * 33], s[3 * 33]); o.z = pk2(s[4 * 33], s[5 * 33]); o.w = pk2(s[6 * 33], s[7 * 33]);
        *(u32x4*)(WT + (size_t)(dst_row0 + n) * K + k0 + 8 * c) = o; }
    asm volatile("s_waitcnt lgkmcnt(0)" ::: "memory");
}

DI void norm_phase(const Ctx& F, const float* xsrc, float* xdst, const bf16_t* Y, const float* gpost, float coef, const float* gpre, bf16_t* XN,
                   const float* Wg, const float* gate_b, float* gates) {
    LAS float* wgT = (LAS float*)F.lds;
    if (Wg) {
        for (int i = F.tid; i < 1024 * 8; i += NTHREADS) wgT[(i & 7) * 1024 + (i >> 3)] = Wg[(size_t)(i >> 3) * MIXN + (i & 7)];
        __syncthreads();
    }
    const int gw = F.bid * 8 + F.wave, NGW = F.G * 8, lane = F.lane;
    f32x4 gpo[4], gpr[4];
#pragma unroll
    for (int j = 0; j < 4; ++j) { gpo[j] = Y ? ((const f32x4*)gpost)[64 * j + lane] * coef : (f32x4){0.f, 0.f, 0.f, 0.f}; gpr[j] = gpre ? ((const f32x4*)gpre)[64 * j + lane] : (f32x4){0.f, 0.f, 0.f, 0.f}; }
    f32x4 gb0 = {0.f, 0.f, 0.f, 0.f}, gb1 = {0.f, 0.f, 0.f, 0.f};
    if (Wg) { gb0 = *(const f32x4*)gate_b; gb1 = *(const f32x4*)(gate_b + 4); }
    constexpr int NR = 2;
    for (int row0 = gw; row0 < M; row0 += NGW * NR) {
        f32x4 v[NR][4]; u32x2 y[NR][4];
#pragma unroll
        for (int r = 0; r < NR; ++r) {
            const int row = row0 + NGW * r, rowc = row < M ? row : row0;
            const f32x4* xr = (const f32x4*)(xsrc + (size_t)rowc * D) + lane;
#pragma unroll
            for (int j = 0; j < 4; ++j) v[r][j] = __builtin_nontemporal_load(xr + 64 * j);
            if (Y) { const u32x2* yr = (const u32x2*)(Y + (size_t)rowc * D) + lane;
#pragma unroll
                for (int j = 0; j < 4; ++j) y[r][j] = __builtin_nontemporal_load(yr + 64 * j); }
            else {
#pragma unroll
                for (int j = 0; j < 4; ++j) y[r][j] = (u32x2){0u, 0u}; }
        }
#pragma unroll
        for (int r = 0; r < NR; ++r) {
            const int row = row0 + NGW * r;
            if (row < M) {
                if (Y) {
                    f32x4 yf[4]; float s = 0.f;
#pragma unroll
                    for (int j = 0; j < 4; ++j) { yf[j] = (f32x4){bf_lo(y[r][j].x), bf_hi(y[r][j].x), bf_lo(y[r][j].y), bf_hi(y[r][j].y)}; s += (yf[j][0] * yf[j][0] + yf[j][1] * yf[j][1]) + (yf[j][2] * yf[j][2] + yf[j][3] * yf[j][3]); }
                    const float rstd = 1.f / sqrtf(wave_sum_dpp(s) * (1.f / D) + EPS);
                    f32x4* xo = (f32x4*)(xdst + (size_t)row * D) + lane;
#pragma unroll
                    for (int j = 0; j < 4; ++j) { v[r][j] = v[r][j] + yf[j] * gpo[j] * rstd; xo[64 * j] = v[r][j]; }
                }
                if (gpre) {
                    float s = 0.f;
#pragma unroll
                    for (int j = 0; j < 4; ++j) s += (v[r][j][0] * v[r][j][0] + v[r][j][1] * v[r][j][1]) + (v[r][j][2] * v[r][j][2] + v[r][j][3] * v[r][j][3]);
                    const float rstd = 1.f / sqrtf(wave_sum_dpp(s) * (1.f / D) + EPS);
                    u32x2* o8 = (u32x2*)(XN + (size_t)row * D) + lane;
#pragma unroll
                    for (int j = 0; j < 4; ++j) { v[r][j] = v[r][j] * gpr[j] * rstd; u32x2 w; w.x = pk2(v[r][j][0], v[r][j][1]); w.y = pk2(v[r][j][2], v[r][j][3]); o8[64 * j] = w; }
                    if (Wg) {
                        float ga[8];
#pragma unroll
                        for (int g = 0; g < 8; ++g) {
                            float a = 0.f;
#pragma unroll
                            for (int j = 0; j < 4; ++j) { const f32x4 w4 = *(const LAS f32x4*)(wgT + g * 1024 + 256 * j + 4 * lane); a += (w4[0] * v[r][j][0] + w4[1] * v[r][j][1]) + (w4[2] * v[r][j][2] + w4[3] * v[r][j][3]); }
                            ga[g] = wave_sum_dpp(a);
                        }
                        if (lane == 0) {
                            f32x4 o0 = {ga[0] + gb0[0], ga[1] + gb0[1], ga[2] + gb0[2], ga[3] + gb0[3]}, o1 = {ga[4] + gb1[0], ga[5] + gb1[1], ga[6] + gb1[2], ga[7] + gb1[3]};
                            *(f32x4*)(gates + (size_t)row * 8) = o0; *(f32x4*)(gates + (size_t)row * 8 + 4) = o1;
                        }
                    }
                }
            }
        }
    }
    if (Wg) __syncthreads();
}

constexpr int I_IN = 16 * 176, I_OUT = 44 * 32, I_MI = 16 * 96, I_MO = 16 * 32;
DI void conv_one(const Ctx& F, int type, int mi, int r, LAS float* scr) {
    const int lane = F.lane;
    if (type == 0) {
        const int kb = r / 176, nb = r % 176, np = 32 * nb, pn = np >> 8, j = np & 255, bj = j >> 7, jj = j & 127;
        transpose_item(F.ffn_w_in + (size_t)mi * D * 2 * DFF, 2 * DFF, D, 64 * kb, bj * DFF + 128 * pn + jj, (bf16_t*)(F.ws + WS_WIN) + (size_t)mi * 2 * DFF * D, np, scr, lane);
    } else if (type == 1) {
        const int kb = r / 32, nb = r % 32;
        transpose_item(F.ffn_w_out + (size_t)mi * DFF * D, D, DFF, 64 * kb, 32 * nb, (bf16_t*)(F.ws + WS_WOUT) + (size_t)mi * D * DFF, 32 * nb, scr, lane);
    } else if (type == 2) {
        const int kb = r / 96, nb = r % 96, np = 32 * nb, region = np >> 9, off = np & 511;
        int src;
        if (region < 2) { const int j = np & 255, bj = j >> 7, jj = j & 127, grp = jj >> 5; src = (np - j) + grp * 64 + bj * 32; }
        else if (region == 2) src = 1536 + off;
        else if (region == 3) src = 2560 + off;
        else if (region == 4) src = 1024 + off;
        else src = 2048 + off;
        transpose_item(F.mix_w_in + (size_t)mi * D * MIXN, MIXN, D, 64 * kb, src, (bf16_t*)(F.ws + WS_WMIXIN) + (size_t)mi * 3072 * D, np, scr, lane);
    } else {
        const int kb = r / 32, nb = r % 32;
        transpose_item(F.mix_w_out + (size_t)mi * D * D, D, D, 64 * kb, 32 * nb, (bf16_t*)(F.ws + WS_WMIXOUT) + (size_t)mi * D * D, 32 * nb, scr, lane);
    }
}
template <int GRP> DI void conv_group(const Ctx& F, int worker, int nworkers, LAS float* scr) {
    constexpr int NSEG = GRP == 0 ? 2 : (GRP == 3 ? 2 : 4);
    constexpr int types[4][4] = {{0, 1, 0, 0}, {2, 3, 0, 1}, {0, 1, 2, 3}, {0, 1, 0, 0}};
    constexpr int idxs[4][4] = {{0, 0, 0, 0}, {0, 0, 1, 1}, {2, 2, 1, 1}, {3, 3, 0, 0}};
    constexpr int cnt[4] = {I_IN, I_OUT, I_MI, I_MO};
    int total = 0;
#pragma unroll
    for (int sg = 0; sg < NSEG; ++sg) total += cnt[types[GRP][sg]];
    for (int it = worker; it < total; it += nworkers) {
        int r = it;
#pragma unroll
        for (int sg = 0; sg < NSEG; ++sg) {
            const int n = cnt[types[GRP][sg]];
            if (r >= 0 && r < n) conv_one(F, types[GRP][sg], idxs[GRP][sg], r, scr);
            r -= n;
        }
    }
}

DI void prologue(const Ctx& F) {
    LAS float* scr = (LAS float*)(F.lds + F.wave * 16384);
    const int gw = F.bid * 8 + F.wave, NGW = F.G * 8, lane = F.lane;
    conv_group<0>(F, gw, NGW, scr);
    norm_phase(F, F.x, nullptr, nullptr, nullptr, 0.f, F.norm_g, (bf16_t*)(F.ws + WS_XN), nullptr, nullptr, nullptr);
}

DI float silu_f(float v) { return v / (1.f + __expf(-v)); }
DI bf16x8 ld_bf16x8_g(const bf16_t* p) { return *(const bf16x8*)p; }

DI void m1_phase(const Ctx& F, int l) {
    const int tid = F.tid, lane = F.lane, wave = F.wave;
    LAS bf16_t* KW = (LAS bf16_t*)F.lds;
    LAS float* wl = (LAS float*)(F.lds + 9216);
    const float* MLQK = (const float*)(F.ws + WS_MLQK);
    const float* gates = (const float*)(F.ws + WS_GATES);
    const bf16_t* VT = (const bf16_t*)(F.ws + WS_VTML);
    float* UHAT = (float*)(F.ws + WS_UHAT); float* NHAT = (float*)(F.ws + WS_NHAT);
    float* BCUM = (float*)(F.ws + WS_BCUM); float* LOGI = (float*)(F.ws + WS_LOGI);
    float* CHS = (float*)(F.ws + WS_CHS);
    bf16_t* QC = (bf16_t*)(F.ws + WS_QC); bf16_t* KC = (bf16_t*)(F.ws + WS_KC);
    LAS float* cw = (LAS float*)(F.lds + 16384); LAS float* cb = cw + 2048;
    for (int i = tid; i < 2560; i += NTHREADS) cw[i] = (i < 2048) ? F.conv_w[(size_t)l * 2048 + i] : F.conv_b[(size_t)l * 512 + (i - 2048)];
    __syncthreads();
    const int tl = tid >> 3, d0 = (tid & 7) * 8, r = lane & 31, hh = lane >> 5;
    float gi = 0.f, gf = 0.f; f32x4 xin[2][4][2];
#define M1_ISSUE(U) do { const int bh_ = (U) & 7, c_ = (U) >> 3, b_ = bh_ >> 2, h_ = bh_ & 3, s0_ = c_ * 64, tok0_ = b_ * SEQ + s0_; \
        gi = gates[(size_t)(tok0_ + lane) * 8 + h_]; gf = gates[(size_t)(tok0_ + lane) * 8 + 4 + h_]; \
        _Pragma("unroll") for (int which = 0; which < 2; ++which) _Pragma("unroll") for (int j = 0; j < 4; ++j) { const int s_ = s0_ + tl - 3 + j; \
            const float* xp = MLQK + (size_t)(b_ * SEQ + (s_ < 0 ? 0 : s_)) * 512 + which * 256 + h_ * 64 + d0; \
            xin[which][j][0] = *(const f32x4*)xp; xin[which][j][1] = *(const f32x4*)(xp + 4); } } while (0)
    if (F.bid < 1024) M1_ISSUE(F.bid);
    for (int unit = F.bid; unit < 1024; unit += F.G) {
        const int bh = unit & 7, c = unit >> 3, b = bh >> 2, h = bh & 3, s0 = c * 64, tok0 = b * SEQ + s0;
        bf16x8 vfr[4];
        { const bf16_t* ap = VT + ((size_t)(bh * 128 + 32 * (wave >> 1) + r)) * SEQ + s0 + 8 * hh;
#pragma unroll
          for (int ks = 0; ks < 4; ++ks) vfr[ks] = *(const bf16x8*)(ap + 16 * ks); }
        if (wave == 0) {
            const float lf = fminf(gf, 0.f) - log1pf(__expf(-fabsf(gf)));
            float bc = lf;
#pragma unroll
            for (int o = 1; o < 64; o <<= 1) { const float t = shfl_from(bc, (lane - o) & 63); if (lane >= o) bc += t; }
            const float bl = shfl_from(bc, 63);
            const float a = bl - bc + gi;
            const float amax = wave_max_dpp(a);
            wl[lane] = __expf(a - amax);
            BCUM[bh * SEQ + s0 + lane] = bc; LOGI[bh * SEQ + s0 + lane] = gi;
            if (lane == 0) { CHS[bh * 128 + c] = bl; CHS[1024 + bh * 128 + c] = amax; }
        }
        float kv[8];
#pragma unroll
        for (int which = 0; which < 2; ++which) {
            const int ch = which * 256 + h * 64 + d0;
            float a8[8];
            { const f32x4 b0 = *(const LAS f32x4*)(cb + ch), b1 = *(const LAS f32x4*)(cb + ch + 4);
              a8[0] = b0[0]; a8[1] = b0[1]; a8[2] = b0[2]; a8[3] = b0[3]; a8[4] = b1[0]; a8[5] = b1[1]; a8[6] = b1[2]; a8[7] = b1[3]; }
#pragma unroll
            for (int j = 0; j < 4; ++j) {
                const float keep = (s0 + tl - 3 + j >= 0) ? 1.f : 0.f;
                const f32x4 x0 = xin[which][j][0], x1 = xin[which][j][1];
                const f32x4 w0 = *(const LAS f32x4*)(cw + j * 512 + ch) * keep, w1 = *(const LAS f32x4*)(cw + j * 512 + ch + 4) * keep;
                a8[0] += w0[0] * x0[0]; a8[1] += w0[1] * x0[1]; a8[2] += w0[2] * x0[2]; a8[3] += w0[3] * x0[3];
                a8[4] += w1[0] * x1[0]; a8[5] += w1[1] * x1[1]; a8[6] += w1[2] * x1[2]; a8[7] += w1[3] * x1[3];
            }
            const float sc = which == 0 ? 0.125f : 1.f;
#pragma unroll
            for (int i = 0; i < 8; ++i) a8[i] = silu_f(a8[i]) * sc;
            u32x4 w; w.x = pk2(a8[0], a8[1]); w.y = pk2(a8[2], a8[3]); w.z = pk2(a8[4], a8[5]); w.w = pk2(a8[6], a8[7]);
            bf16_t* dst = (which == 0 ? QC : KC) + ((size_t)bh * SEQ + s0 + tl) * 64 + d0;
            *(u32x4*)dst = w;
            if (which == 1) {
#pragma unroll
                for (int i = 0; i < 8; ++i) kv[i] = a8[i];
            }
        }
        if (unit + F.G < 1024) M1_ISSUE(unit + F.G);
        __syncthreads();
        { const float wt = wl[tl];
#pragma unroll
          for (int i = 0; i < 8; ++i) { const unsigned p = pk2(wt * kv[i], 0.f); KW[(d0 + i) * 72 + tl] = (bf16_t)(p & 0xffffu); } }
        __syncthreads();
        { const int et = wave >> 1, dt = wave & 1;
          f32x16 acc;
#pragma unroll
          for (int i = 0; i < 16; ++i) acc[i] = 0.f;
          const LAS bf16_t* bp = KW + (32 * dt + r) * 72 + 8 * hh;
#pragma unroll
          for (int ks = 0; ks < 4; ++ks) { const bf16x8 bb = *(const LAS bf16x8*)(bp + 16 * ks); acc = MFMA32(vfr[ks], bb, acc); }
          float* up = UHAT + ((size_t)(bh * 128 + c) * 128 + 32 * et) * 64 + 32 * dt + r;
#pragma unroll
          for (int i = 0; i < 16; ++i) up[crow(i, hh) * 64] = acc[i];
        }
        if (tid < 64) {
            float s = 0.f;
#pragma unroll
            for (int q8 = 0; q8 < 8; ++q8) { const u32x4 v = *(const LAS u32x4*)(KW + tid * 72 + 8 * q8);
                s += (bf_lo(v.x) + bf_hi(v.x)) + (bf_lo(v.y) + bf_hi(v.y)) + (bf_lo(v.z) + bf_hi(v.z)) + (bf_lo(v.w) + bf_hi(v.w)); }
            NHAT[(size_t)(bh * 128 + c) * 64 + tid] = s;
        }
        __syncthreads();
    }
}

#undef M1_ISSUE
DI void m2_phase(const Ctx& F, int l) {
    const float* UHAT = (const float*)(F.ws + WS_UHAT); const float* NHAT = (const float*)(F.ws + WS_NHAT);
    bf16_t* CPREV = (bf16_t*)(F.ws + WS_CPREV); float* NPREV = (float*)(F.ws + WS_NPREV);
    float* CHS = (float*)(F.ws + WS_CHS);
    LAS float* sco = (LAS float*)F.lds;
    for (int i = F.tid; i < 2048; i += NTHREADS) sco[i] = CHS[i];
    __syncthreads();
    for (int idx = (F.wave * F.G + F.bid) * 64 + F.lane; idx < 8 * 8256; idx += F.G * NTHREADS) {
        const int bh = idx / 8256, e = idx - bh * 8256;
        const float* __restrict__ src; float* __restrict__ dst = nullptr; bf16_t* __restrict__ dst16 = nullptr; int stride;
        if (e < 8192) { src = UHAT + (size_t)bh * 128 * 8192 + e; dst16 = CPREV + (size_t)bh * 128 * 8192 + e; stride = 8192; }
        else { src = NHAT + (size_t)bh * 128 * 64 + (e - 8192); dst = NPREV + (size_t)bh * 128 * 64 + (e - 8192); stride = 64; }
        const LAS float* bl = sco + bh * 128; const LAS float* am = sco + 1024 + bh * 128; float* mp = CHS + 2048 + bh * 128;
        float m = 0.f, C = 0.f;
        for (int c = 0; c < 128; c += 32) {
            float u[32];
#pragma unroll
            for (int i = 0; i < 32; ++i) u[i] = __builtin_nontemporal_load(src + (size_t)(c + i) * stride);
#pragma unroll
            for (int i = 0; i < 32; ++i) {
                if (dst16) dst16[(size_t)(c + i) * stride] = (bf16_t)(pk2(C, 0.f) & 0xffffu); else dst[(size_t)(c + i) * stride] = C;
                if (e == 0) mp[c + i] = m;
                const float blc = bl[c + i], amc = am[c + i];
                const float mn = fmaxf(blc + m, amc);
                C = __expf(blc + m - mn) * C + __expf(amc - mn) * u[i];
                m = mn;
            }
        }
    }
}

DI void m3_phase(const Ctx& F, int l) {
    int tid = F.tid; asm volatile("" : "+v"(tid));
    const int lane = tid & 63, wave = F.wave;
    LAS unsigned char* L = F.lds;
    LAS bf16_t* Qs = (LAS bf16_t*)(L + 0); LAS bf16_t* Ks = (LAS bf16_t*)(L + 9216); LAS bf16_t* VTs = (LAS bf16_t*)(L + 18432); LAS bf16_t* Cs = (LAS bf16_t*)(L + 36864);
    LAS bf16_t* Ws = (LAS bf16_t*)(L + 55296); LAS bf16_t* Qds = (LAS bf16_t*)(L + 64512); LAS float* Hs = (LAS float*)(L + 73728);
    LAS float* vu = (LAS float*)(L + 107520); LAS float* vmm = vu + 64; LAS float* vdec = vu + 128; LAS float* vem = vu + 192; LAS float* vnp = vu + 256; LAS float* vhd = vu + 320;
    const bf16_t* QC = (const bf16_t*)(F.ws + WS_QC); const bf16_t* KC = (const bf16_t*)(F.ws + WS_KC);
    const bf16_t* VT = (const bf16_t*)(F.ws + WS_VTML); const bf16_t* MLO = (const bf16_t*)(F.ws + WS_MLO);
    const bf16_t* CPREV = (const bf16_t*)(F.ws + WS_CPREV); const float* NPREV = (const float*)(F.ws + WS_NPREV);
    const float* BCUM = (const float*)(F.ws + WS_BCUM); const float* LOGI = (const float*)(F.ws + WS_LOGI); const float* CHS = (const float*)(F.ws + WS_CHS);
    bf16_t* YMIX = (bf16_t*)(F.ws + WS_XN);
    LAS float* ng = vu + 384;
    if (tid < 128) ng[tid] = F.ml_norm_g[(size_t)l * 128 + tid];
    __syncthreads();
    const int tl = tid >> 3, d0 = (tid & 7) * 8, r = lane & 31, hh = lane >> 5;
    u32x4 gq, gk, gv[2], gc[2]; float bs = 0.f, li = 0.f, mprev = 0.f, npv = 0.f;
#define M3_ISSUE(U) do { const int bh_ = (U) & 7, c_ = (U) >> 3, s0_ = c_ * 64; \
        gq = __builtin_nontemporal_load((const u32x4*)(QC + ((size_t)bh_ * SEQ + s0_ + tl) * 64 + d0)); gk = __builtin_nontemporal_load((const u32x4*)(KC + ((size_t)bh_ * SEQ + s0_ + tl) * 64 + d0)); \
        _Pragma("unroll") for (int i = 0; i < 2; ++i) { const int idx = tid + NTHREADS * i, e = idx >> 3, ch = idx & 7; \
            gv[i] = __builtin_nontemporal_load((const u32x4*)(VT + ((size_t)(bh_ * 128 + e)) * SEQ + s0_ + ch * 8)); \
            gc[i] = __builtin_nontemporal_load((const u32x4*)(CPREV + ((size_t)(bh_ * 128 + c_) * 128 + e) * 64 + ch * 8)); } \
        bs = BCUM[bh_ * SEQ + s0_ + lane]; li = LOGI[bh_ * SEQ + s0_ + lane]; mprev = CHS[2048 + bh_ * 128 + c_]; \
        npv = NPREV[(size_t)(bh_ * 128 + c_) * 64 + lane]; } while (0)
    if (F.bid < 1024) M3_ISSUE(F.bid);
    for (int unit = F.bid; unit < 1024; unit += F.G) {
        const int bh = unit & 7, c = unit >> 3, b = bh >> 2, h = bh & 3, s0 = c * 64, tok0 = b * SEQ + s0;
        const bf16_t* op = MLO + (size_t)(tok0 + tl) * 512 + h * 128 + (tid & 7) * 16;
        const u32x4 o0 = *(const u32x4*)op, o1 = *(const u32x4*)(op + 8);
        *(LAS u32x4*)(Qs + tl * 72 + d0) = gq; *(LAS u32x4*)(Ks + tl * 72 + d0) = gk;
#pragma unroll
        for (int i = 0; i < 2; ++i) {
            const int idx = tid + NTHREADS * i, e = idx >> 3, ch = idx & 7;
            *(LAS u32x4*)(VTs + e * 72 + ch * 8) = gv[i]; *(LAS u32x4*)(Cs + e * 72 + ch * 8) = gc[i];
        }
        if (wave == 0) {
            const float u = li - bs;
            float pm = u;
#pragma unroll
            for (int o = 1; o < 64; o <<= 1) { const float t = shfl_from(pm, (lane - o) & 63); if (lane >= o) pm = fmaxf(pm, t); }
            const float mm = fmaxf(mprev, pm);
            vu[lane] = u; vmm[lane] = mm; vdec[lane] = __expf(mprev - mm); vem[lane] = __expf(-(bs + mm));
        } else if (wave == 1) {
            vnp[lane] = npv;
        }
        if (unit + F.G < 1024) M3_ISSUE(unit + F.G);
        __syncthreads();
        { const u32x4 q = *(const LAS u32x4*)(Qs + tl * 72 + d0); const float dc = vdec[tl];
          u32x4 w; w.x = pk2(bf_lo(q.x) * dc, bf_hi(q.x) * dc); w.y = pk2(bf_lo(q.y) * dc, bf_hi(q.y) * dc); w.z = pk2(bf_lo(q.z) * dc, bf_hi(q.z) * dc); w.w = pk2(bf_lo(q.w) * dc, bf_hi(q.w) * dc);
          *(LAS u32x4*)(Qds + tl * 72 + d0) = w; }
        if (wave < 4) {
            const int jt = wave >> 1, st = wave & 1;
            f32x16 acc;
#pragma unroll
            for (int i = 0; i < 16; ++i) acc[i] = 0.f;
            const LAS bf16_t* ap = Qs + (32 * jt + r) * 72 + 8 * hh; const LAS bf16_t* bp = Ks + (32 * st + r) * 72 + 8 * hh;
#pragma unroll
            for (int ks = 0; ks < 4; ++ks) acc = MFMA32(*(const LAS bf16x8*)(ap + 16 * ks), *(const LAS bf16x8*)(bp + 16 * ks), acc);
            const int s = 32 * st + r; const float us = vu[s];
#pragma unroll
            for (int i = 0; i < 16; ++i) {
                const int j = 32 * jt + crow(i, hh);
                const float val = (s <= j) ? __expf(us - vmm[j]) * acc[i] : 0.f;
                Ws[j * 72 + s] = (bf16_t)(pk2(val, 0.f) & 0xffffu);
            }
        }
        __syncthreads();
        { const int jt = wave >> 2, et = wave & 3;
          f32x16 acc;
#pragma unroll
          for (int i = 0; i < 16; ++i) acc[i] = 0.f;
          const LAS bf16_t* a1 = Ws + (32 * jt + r) * 72 + 8 * hh; const LAS bf16_t* b1 = VTs + (32 * et + r) * 72 + 8 * hh;
          const LAS bf16_t* a2 = Qds + (32 * jt + r) * 72 + 8 * hh; const LAS bf16_t* b2 = Cs + (32 * et + r) * 72 + 8 * hh;
#pragma unroll
          for (int ks = 0; ks < 4; ++ks) acc = MFMA32(*(const LAS bf16x8*)(a1 + 16 * ks), *(const LAS bf16x8*)(b1 + 16 * ks), acc);
#pragma unroll
          for (int ks = 0; ks < 4; ++ks) acc = MFMA32(*(const LAS bf16x8*)(a2 + 16 * ks), *(const LAS bf16x8*)(b2 + 16 * ks), acc);
#pragma unroll
          for (int i = 0; i < 16; ++i) Hs[(32 * jt + crow(i, hh)) * 132 + 32 * et + r] = acc[i];
        }
        if (tid < 64) {
            float rs = 0.f, qn = 0.f;
#pragma unroll
            for (int q8 = 0; q8 < 8; ++q8) {
                const u32x4 v = *(const LAS u32x4*)(Ws + tid * 72 + 8 * q8);
                rs += (bf_lo(v.x) + bf_hi(v.x)) + (bf_lo(v.y) + bf_hi(v.y)) + (bf_lo(v.z) + bf_hi(v.z)) + (bf_lo(v.w) + bf_hi(v.w));
                const u32x4 q = *(const LAS u32x4*)(Qds + tid * 72 + 8 * q8);
                const LAS float* np = vnp + 8 * q8;
                qn += bf_lo(q.x) * np[0] + bf_hi(q.x) * np[1] + bf_lo(q.y) * np[2] + bf_hi(q.y) * np[3] + bf_lo(q.z) * np[4] + bf_hi(q.z) * np[5] + bf_lo(q.w) * np[6] + bf_hi(q.w) * np[7];
            }
            const float den = rs + qn;
            vhd[tid] = 1.f / fmaxf(fabsf(den), vem[tid]);
        }
        __syncthreads();
        { const int j = tl, e0 = (tid & 7) * 16; const float hd = vhd[j];
          f32x4 hv[4]; float ss = 0.f;
#pragma unroll
          for (int i = 0; i < 4; ++i) { hv[i] = *(const LAS f32x4*)(Hs + j * 132 + e0 + 4 * i) * hd; ss += (hv[i][0] * hv[i][0] + hv[i][1] * hv[i][1]) + (hv[i][2] * hv[i][2] + hv[i][3] * hv[i][3]); }
          ss += dpp_f(ss, 0); ss += dpp_f(ss, 1); ss += dpp_f(ss, 2);
          const float rstd = 1.f / sqrtf(ss * (1.f / 128.f) + EPS);
          const unsigned ow[8] = {o0.x, o0.y, o0.z, o0.w, o1.x, o1.y, o1.z, o1.w};
          unsigned res[8];
#pragma unroll
          for (int i = 0; i < 4; ++i) {
              const f32x4 g = *(const LAS f32x4*)(ng + e0 + 4 * i);
              const float oa = bf_lo(ow[2 * i]), ob = bf_hi(ow[2 * i]), oc = bf_lo(ow[2 * i + 1]), od = bf_hi(ow[2 * i + 1]);
              const float v0 = hv[i][0] * rstd * g[0] / (1.f + __expf(-oa)), v1 = hv[i][1] * rstd * g[1] / (1.f + __expf(-ob));
              const float v2 = hv[i][2] * rstd * g[2] / (1.f + __expf(-oc)), v3 = hv[i][3] * rstd * g[3] / (1.f + __expf(-od));
              res[2 * i] = pk2(v0, v1); res[2 * i + 1] = pk2(v2, v3);
          }
          bf16_t* yp = YMIX + (size_t)(tok0 + j) * 1024 + 512 + h * 128 + e0;
          u32x4 w0 = {res[0], res[1], res[2], res[3]}, w1 = {res[4], res[5], res[6], res[7]};
          *(u32x4*)yp = w0; *(u32x4*)(yp + 8) = w1;
        }
        __syncthreads();
    }
}

#undef M3_ISSUE
constexpr float AT_THR = 6.f;
constexpr int AT_STAGE = 36864, AT_K1 = 9216, AT_V = 18432, AT_SG_OFF = LDS_BYTES - 2048;
DI void attn_unit(const Ctx& F, int l, int bh, int qb, float lam) {
    const int tid = F.tid, lane = F.lane, wave = F.wave, c = wave >> 2, rg = wave & 3, r = lane & 31, hh = lane >> 5;
    const int b = bh >> 2, h = bh & 3;
    LAS unsigned char* L = F.lds;
    const bf16_t* Qg = (const bf16_t*)(F.ws + WS_Q); const bf16_t* Kg = (const bf16_t*)(F.ws + WS_K); const bf16_t* VTg = (const bf16_t*)(F.ws + WS_VTDA);
    bf16_t* YMIX = (bf16_t*)(F.ws + WS_XN);
    const int q0 = qb * 128 + rg * 32;
    bf16x8 qf[4];
    { const bf16_t* qp = Qg + ((size_t)((bh * 2 + c) * SEQ) + q0 + r) * 64 + 8 * hh;
#pragma unroll
      for (int ks = 0; ks < 4; ++ks) qf[ks] = *(const bf16x8*)(qp + 16 * ks); }
    const int ntile = 2 * qb + 2, my_n = (rg < 2) ? ntile - 1 : ntile;
    const int krow = tid >> 3, kch = tid & 7;
    const bf16_t* k0p = Kg + ((size_t)((bh * 2 + 0) * SEQ) + krow) * 64 + kch * 8;
    const bf16_t* k1p = Kg + ((size_t)((bh * 2 + 1) * SEQ) + krow) * 64 + kch * 8;
    const bf16_t* v0p = VTg + ((size_t)(bh * 128 + krow)) * SEQ + kch * 8;
    const bf16_t* v1p = VTg + ((size_t)(bh * 128 + 64 + krow)) * SEQ + kch * 8;
    const int kdst = krow * 144 + kch * 16;
    u32x4 pk0, pk1, pv0, pv1;
    pk0 = *(const u32x4*)k0p; pk1 = *(const u32x4*)k1p; pv0 = *(const u32x4*)v0p; pv1 = *(const u32x4*)v1p;
    *(LAS u32x4*)(L + kdst) = pk0; *(LAS u32x4*)(L + AT_K1 + kdst) = pk1; *(LAS u32x4*)(L + AT_V + kdst) = pv0; *(LAS u32x4*)(L + AT_V + 64 * 144 + kdst) = pv1;
    if (ntile > 1) { pk0 = *(const u32x4*)(k0p + 64 * 64); pk1 = *(const u32x4*)(k1p + 64 * 64); pv0 = *(const u32x4*)(v0p + 64); pv1 = *(const u32x4*)(v1p + 64); }
    __syncthreads();
    f32x16 o[4];
#pragma unroll
    for (int dt = 0; dt < 4; ++dt)
#pragma unroll
        for (int i = 0; i < 16; ++i) o[dt][i] = 0.f;
    float m_run = -30.f, l_run = 0.f;
    bf16x8 pb[4];
#pragma unroll
    for (int i = 0; i < 4; ++i) pb[i] = (bf16x8){0, 0, 0, 0, 0, 0, 0, 0};
    const int kap = (r & ~12) | ((r & 4) << 1) | ((r & 8) >> 1);
    const int koff = c * AT_K1 + kap * 144 + 16 * hh, voff = AT_V + r * 144 + 16 * hh;
#define AT_STAGE_STEP(tw) do { if ((tw) < ntile) { LAS unsigned char* S2 = L + ((tw) & 1) * AT_STAGE; \
        *(LAS u32x4*)(S2 + kdst) = pk0; *(LAS u32x4*)(S2 + AT_K1 + kdst) = pk1; *(LAS u32x4*)(S2 + AT_V + kdst) = pv0; *(LAS u32x4*)(S2 + AT_V + 64 * 144 + kdst) = pv1; \
        if ((tw) + 1 < ntile) { const size_t ko = (size_t)((tw) + 1) * 64 * 64, vo = (size_t)((tw) + 1) * 64; \
            pk0 = *(const u32x4*)(k0p + ko); pk1 = *(const u32x4*)(k1p + ko); pv0 = *(const u32x4*)(v0p + vo); pv1 = *(const u32x4*)(v1p + vo); } } } while (0)
    if (c == 1) __syncthreads();
    for (int t = 0; t < ntile; ++t) {
        LAS unsigned char* S = L + (t & 1) * AT_STAGE;
        if (c == 1) AT_STAGE_STEP(t + 1);
        {
            f32x16 p0, p1;
            const float ninit = (t < my_n) ? -m_run : -1e30f;
#pragma unroll
            for (int i = 0; i < 16; ++i) { p0[i] = ninit; p1[i] = ninit; }
#pragma unroll
            for (int ks = 0; ks < 4; ++ks) { const bf16x8 ka = *(const LAS bf16x8*)(S + koff + 32 * ks); p0 = MFMA32(ka, qf[ks], p0); }
#pragma unroll
            for (int ks = 0; ks < 4; ++ks) { const bf16x8 kb = *(const LAS bf16x8*)(S + koff + 32 * 144 + 32 * ks); p1 = MFMA32(kb, qf[ks], p1); }
            float mx0 = max3f(p0[0], p0[1], p0[2]);
#pragma unroll
            for (int i = 3; i < 15; i += 2) mx0 = max3f(mx0, p0[i], p0[i + 1]);
            mx0 = fmaxf(mx0, p0[15]);
            float ps = 0.f;
#pragma unroll
            for (int i = 0; i < 16; ++i) { p0[i] = __builtin_amdgcn_exp2f(p0[i]); ps += p0[i]; }
            float mx = max3f(mx0, p1[0], p1[1]);
#pragma unroll
            for (int i = 2; i < 16; i += 2) mx = max3f(mx, p1[i], p1[i + 1]);
            mx = half_max(mx);
            if (__any(mx > AT_THR)) {
                const float delta = fmaxf(mx, 0.f);
                const float alpha = __builtin_amdgcn_exp2f(-delta);
                m_run += delta; l_run *= alpha; ps *= alpha;
#pragma unroll
                for (int i = 0; i < 16; ++i) { p0[i] *= alpha; p1[i] -= delta; }
#pragma unroll
                for (int dt = 0; dt < 4; ++dt)
#pragma unroll
                    for (int i = 0; i < 16; ++i) o[dt][i] *= alpha;
            }
#pragma unroll
            for (int i = 0; i < 16; ++i) { p1[i] = __builtin_amdgcn_exp2f(p1[i]); ps += p1[i]; }
            l_run += ps;
            { u32x4 w;
              w.x = pk2(p0[0], p0[1]); w.y = pk2(p0[2], p0[3]); w.z = pk2(p0[4], p0[5]); w.w = pk2(p0[6], p0[7]); pb[0] = __builtin_bit_cast(bf16x8, w);
              w.x = pk2(p0[8], p0[9]); w.y = pk2(p0[10], p0[11]); w.z = pk2(p0[12], p0[13]); w.w = pk2(p0[14], p0[15]); pb[1] = __builtin_bit_cast(bf16x8, w);
              w.x = pk2(p1[0], p1[1]); w.y = pk2(p1[2], p1[3]); w.z = pk2(p1[4], p1[5]); w.w = pk2(p1[6], p1[7]); pb[2] = __builtin_bit_cast(bf16x8, w);
              w.x = pk2(p1[8], p1[9]); w.y = pk2(p1[10], p1[11]); w.z = pk2(p1[12], p1[13]); w.w = pk2(p1[14], p1[15]); pb[3] = __builtin_bit_cast(bf16x8, w); }
            asm volatile("" : "+v"(pb[0]), "+v"(pb[1]), "+v"(pb[2]), "+v"(pb[3]), "+v"(l_run));
        }
        __syncthreads();
        if (c == 0) AT_STAGE_STEP(t + 1);
#pragma unroll
        for (int st = 0; st < 4; ++st)
#pragma unroll
            for (int dt = 0; dt < 4; ++dt) {
                const bf16x8 va = *(const LAS bf16x8*)(S + voff + dt * 32 * 144 + 32 * st);
                o[dt] = MFMA32(va, pb[st], o[dt]);
            }
        __syncthreads();
    }
    if (c == 0) __syncthreads();
#undef AT_STAGE_STEP
    const float inv = 1.f / half_sum(l_run);
    LAS float* X = (LAS float*)L;
    if (c == 1) {
#pragma unroll
        for (int dt = 0; dt < 4; ++dt)
#pragma unroll
            for (int i = 0; i < 16; ++i) X[(rg * 128 + 32 * dt + crow(i, hh)) * 32 + r] = o[dt][i] * inv;
    }
    __syncthreads();
    if (c == 0) {
        float ss = 0.f;
#pragma unroll
        for (int dt = 0; dt < 4; ++dt)
#pragma unroll
            for (int i = 0; i < 16; ++i) { const float v = o[dt][i] * inv - lam * X[(rg * 128 + 32 * dt + crow(i, hh)) * 32 + r]; o[dt][i] = v; ss += v * v; }
        ss = half_sum(ss);
        const float li = (l == 0) ? 0.2f : 0.35550907f;
        const float rstd = (1.f - li) / sqrtf(ss * (1.f / 128.f) + EPS);
        const LAS float* sg = (const LAS float*)(F.lds + AT_SG_OFF);
        bf16_t* yp = YMIX + (size_t)(b * SEQ + q0 + r) * 1024 + h * 128;
#pragma unroll
        for (int dt = 0; dt < 4; ++dt)
#pragma unroll
            for (int g4 = 0; g4 < 4; ++g4) {
                const int d = 32 * dt + 8 * g4 + 4 * hh;
                const f32x4 g = *(const LAS f32x4*)(sg + d);
                u32x2 w; w.x = pk2(o[dt][4 * g4] * rstd * g[0], o[dt][4 * g4 + 1] * rstd * g[1]); w.y = pk2(o[dt][4 * g4 + 2] * rstd * g[2], o[dt][4 * g4 + 3] * rstd * g[3]);
                *(u32x2*)(yp + d) = w;
            }
    }
    __syncthreads();
}

DI void attn_m3_phase(const Ctx& F, int l) {
    const float* lv = F.da_lambda + (size_t)l * 256;
    const float s1 = wave_sum_dpp(lv[F.lane] * lv[64 + F.lane]), s2 = wave_sum_dpp(lv[128 + F.lane] * lv[192 + F.lane]);
    const float li = (l == 0) ? 0.2f : 0.35550907f;
    const float lam = expf(s1) - expf(s2) + li;
    if (F.tid < 128) ((LAS float*)(F.lds + AT_SG_OFF))[F.tid] = F.da_subln_g[(size_t)l * 128 + F.tid];
    __syncthreads();
    for (int rep = 0; rep < D_AT; ++rep)
    for (int p = F.bid; p < 256; p += F.G) {
        const int bh = p & 7, i = p >> 3;
#if EN_AT
        attn_unit(F, l, bh, 63 - i, lam);
        attn_unit(F, l, bh, i, lam);
#endif
    }
#if EN_M3
    for (int rep = 0; rep < D_M3; ++rep) m3_phase(F, l);
#endif
}


#define XB_TMO      128
#define XB_XCNT(j)  (256  + 64 * (j))
#define XB_XSUB(j)  (1280 + 64 * (j))
#define XB_XGEN(j)  (2304 + 64 * (j))
#define XB_TOP      3328
#define XB_TOPGEN   3392
#define XCD_BAR_WORDS 3456
#define XB_SPIN_CAP (1u << 22)
DI unsigned xb_ld(unsigned* p)              { return __hip_atomic_load(p, __ATOMIC_RELAXED, __HIP_MEMORY_SCOPE_AGENT); }
DI unsigned xb_add(unsigned* p, unsigned v) { return __hip_atomic_fetch_add(p, v, __ATOMIC_RELAXED, __HIP_MEMORY_SCOPE_AGENT); }
DI unsigned xb_xcc_id() { return (unsigned)__builtin_amdgcn_s_getreg((3 << 11) | 20) & 0xFu; }
#define XB_SPIN(cond, bar) do { unsigned _sp = 0; while (cond) { __builtin_amdgcn_s_sleep(1); \
    if ((++_sp & 255u) == 0u) { if (xb_ld(&(bar)[XB_TMO])) break; if (_sp > XB_SPIN_CAP) { atomicAdd(&(bar)[XB_TMO], 1u); break; } } } } while (0)
struct XcdBarrier { unsigned* bar; unsigned x; volatile LAS unsigned* st; };
DI XcdBarrier xcd_barrier_post(unsigned* bar, volatile LAS unsigned* st) {
    XcdBarrier b; b.bar = bar; b.x = xb_xcc_id(); b.st = st;
    if (threadIdx.x == 0) (void)xb_add(&bar[XB_XCNT(b.x)], 1u);
    return b;
}
DI void xcd_barrier_complete(unsigned* bar, unsigned x, unsigned& nloc, unsigned& nx) {
    const unsigned G = gridDim.x * gridDim.y * gridDim.z;
    unsigned sum, cnt, mine, sp = 0u;
    for (;;) {
        sum = 0u; cnt = 0u; mine = 0u;
#pragma unroll
        for (unsigned j = 0; j < 16; ++j) { const unsigned c = xb_ld(&bar[XB_XCNT(j)]); sum += c; cnt += (c > 0u) ? 1u : 0u; mine = (j == x) ? c : mine; }
        if (sum == G) break;
        __builtin_amdgcn_s_sleep(1);
        if ((++sp & 255u) == 0u) { if (xb_ld(&bar[XB_TMO])) break; if (sp > XB_SPIN_CAP) { atomicAdd(&bar[XB_TMO], 1u); break; } }
    }
    nloc = mine > 0u ? mine : 1u; nx = cnt > 0u ? cnt : 1u;
}
DI void xcd_barrier(const XcdBarrier& b) {
    asm volatile("s_waitcnt vmcnt(0)" ::: "memory");
    __syncthreads();
    if (threadIdx.x == 0) {
        unsigned* bar = b.bar;
        __builtin_amdgcn_s_waitcnt(0);
        unsigned nloc = b.st[0], nx = b.st[1];
        if (nloc == 0u) { xcd_barrier_complete(bar, b.x, nloc, nx); b.st[0] = nloc; b.st[1] = nx; }
        const unsigned old = xb_add(&bar[XB_XSUB(b.x)], 1u);
        const unsigned gen = old / nloc;
        if (old + 1u == (gen + 1u) * nloc) {
            __builtin_amdgcn_fence(__ATOMIC_RELEASE, "agent");
            asm volatile("s_waitcnt vmcnt(0)" ::: "memory");
            const unsigned og = xb_add(&bar[XB_TOP], 1u);
            const unsigned tg = og / nx;
            if (og + 1u == (tg + 1u) * nx) xb_add(&bar[XB_TOPGEN], 1u);
            else XB_SPIN(xb_ld(&bar[XB_TOPGEN]) == tg, bar);
            __builtin_amdgcn_fence(__ATOMIC_ACQUIRE, "agent");
            xb_add(&bar[XB_XGEN(b.x)], 1u);
            asm volatile("s_waitcnt vmcnt(0)" ::: "memory");
        } else {
            XB_SPIN(xb_ld(&bar[XB_XGEN(b.x)]) == gen, bar);
            __builtin_amdgcn_fence(__ATOMIC_ACQUIRE, "agent");
            asm volatile("s_waitcnt vmcnt(0)" ::: "memory");
        }
    }
    __syncthreads();
}

__global__ void __launch_bounds__(NTHREADS, 2) fwd_kernel(Args args) {
    extern __shared__ __attribute__((aligned(16))) unsigned char lds_raw[];
    unsigned char* ws = args.ws;
    bf16_t* XN = (bf16_t*)(ws + WS_XN); bf16_t* ACT = (bf16_t*)(ws + WS_A); bf16_t* Y = (bf16_t*)(ws + WS_Y);
    volatile LAS unsigned* bst = (volatile LAS unsigned*)((LAS unsigned char*)lds_raw + LDS_BYTES - 64);
    if (threadIdx.x < 2) bst[threadIdx.x] = 0u;
    __syncthreads();
    XcdBarrier xbar = xcd_barrier_post((unsigned*)(args.ws + WS_BAR), bst);
    int probe_rep = 0;
    for (int ph = args.ph_lo; ph < args.ph_hi; ++ph) {
        Ctx F;
        F.lds = (LAS unsigned char*)lds_raw;
        { int t = threadIdx.x; asm volatile("" : "+v"(t)); F.tid = t; }
        F.lane = F.tid & 63; F.wave = __builtin_amdgcn_readfirstlane(F.tid >> 6);
        { int bb = blockIdx.x; asm volatile("" : "+s"(bb)); F.bid = bb; }
        F.G = gridDim.x;
        F.x = args.in[0]; F.ffn_w_in = args.in[1]; F.ffn_w_out = args.in[2]; F.norm_g = args.in[3]; F.mix_w_in = args.in[4]; F.mix_w_out = args.in[5];
        F.da_lambda = args.in[6]; F.da_subln_g = args.in[7]; F.conv_w = args.in[8]; F.conv_b = args.in[9]; F.gate_b = args.in[10]; F.ml_norm_g = args.in[11];
        F.out = args.out; F.ws = args.ws;
        if (ph == 0) {
#if EN_PRO
            for (int rep = 0; rep < D_PRO; ++rep) prologue(F);
#endif
        } else {
            const int l = (ph - 1) / 12, k = (ph - 1) % 12;
            const float* ng = F.norm_g + (size_t)l * 6 * D;
            if (k == 0 || k == 9) {
                const int s = (k == 0) ? 0 : 1;
                pg8::Gemm g{XN, (const bf16_t*)(ws + WS_WIN) + (size_t)(l * 2 + s) * 2 * DFF * D, M, 2 * DFF, D};
                pg8::StaticOrder S; S.init(M, 2 * DFF, F.G, F.bid);
                pg8::EpiSwiglu E{ACT};
#if EN_G1
                for (int rep = 0; rep < D_G1; ++rep) pg8::gemm_phase<pg8::EpiSwiglu>(F.lds, F.tid, g, S, E);
#endif
                {
                    const int nun = (M / 256) * (2 * DFF / 256), rem = nun % F.G, first = rem ? rem : 0, nidle = F.G - first;
                    if (F.bid >= first) {
                        LAS float* scr = (LAS float*)(F.lds + F.wave * 16384);
                        const int worker = (F.bid - first) * 8 + F.wave, nworkers = nidle * 8;
                        if (l == 0 && k == 0) conv_group<1>(F, worker, nworkers, scr);
                        else if (l == 0 && k == 9) conv_group<2>(F, worker, nworkers, scr);
                        else if (l == 1 && k == 0) conv_group<3>(F, worker, nworkers, scr);
                    }
                }
            } else if (k == 1 || k == 10 || k == 7) {
                pg8::Gemm g;
                if (k == 7) g = pg8::Gemm{XN, (const bf16_t*)(ws + WS_WMIXOUT) + (size_t)l * D * D, M, D, D};
                else g = pg8::Gemm{ACT, (const bf16_t*)(ws + WS_WOUT) + (size_t)(l * 2 + (k == 1 ? 0 : 1)) * D * DFF, M, D, DFF};
                pg8::StaticOrder S; S.init(M, D, F.G, F.bid);
                pg8::EpiBf16 E{Y, D};
#if EN_G2
                for (int rep = 0; rep < D_G2; ++rep) pg8::gemm_phase<pg8::EpiBf16>(F.lds, F.tid, g, S, E);
#endif
            } else if (k == 2 || k == 8 || k == 11) {
                const float* xsrc = (l == 0 && k == 2) ? F.x : F.out;
                const float* gpost = ng + (k == 2 ? 1 : (k == 8 ? 3 : 5)) * D;
                const float coef = (k == 8) ? 1.f : 0.5f;
                const float* gpre = (k == 2) ? ng + 2 * D : (k == 8 ? ng + 4 * D : (l + 1 < NL ? F.norm_g + (size_t)(l + 1) * 6 * D : nullptr));
                const bool wg = (k == 2);
#if EN_N
                norm_phase(F, xsrc, F.out, Y, gpost, coef, gpre, XN, wg ? F.mix_w_in + (size_t)l * D * MIXN + 3072 : nullptr, F.gate_b + l * 8, (float*)(ws + WS_GATES));
#endif
            } else if (k == 3) {
                const bf16_t* Wt = (const bf16_t*)(ws + WS_WMIXIN) + (size_t)l * 3072 * D;
                { pg8::Gemm g{XN, Wt + (size_t)2048 * D, M, 1024, D}; pg8::StaticOrder S; S.init(M, 1024, F.G, F.bid);
                  pg8::EpiVT E{(bf16_t*)(ws + WS_VTDA), (bf16_t*)(ws + WS_VTML)};
#if EN_G3A
                  for (int rep = 0; rep < D_G3; ++rep) pg8::gemm_phase<pg8::EpiVT>(F.lds, F.tid, g, S, E);
#endif
                }
                { pg8::Gemm g{XN, Wt, M, 2048, D}; pg8::StaticOrder S; S.init(M, 2048, F.G, F.bid);
                  pg8::EpiMix E{(bf16_t*)(ws + WS_Q), (bf16_t*)(ws + WS_K), (float*)(ws + WS_MLQK), (bf16_t*)(ws + WS_MLO)};
#if EN_G3B
                  for (int rep = 0; rep < D_G3; ++rep) pg8::gemm_phase<pg8::EpiMix>(F.lds, F.tid, g, S, E);
#endif
                }
            } else if (k == 4) {
#if EN_M1
                for (int rep = 0; rep < D_M1; ++rep) m1_phase(F, l);
#endif
            } else if (k == 5) {
#if EN_M2
                for (int rep = 0; rep < D_M2; ++rep) m2_phase(F, l);
#endif
            } else if (k == 6) {
                attn_m3_phase(F, l);
            }
        }
        if (PROBE_MASK) {
            const int kk = (ph == 0) ? 12 : (ph - 1) % 12;
            if (((PROBE_MASK >> kk) & 1) && !probe_rep) { probe_rep = 1; --ph; } else probe_rep = 0;
        }
        if (ph + 1 < args.ph_hi) {
            if (args.ph_hi > 4096) cg::this_grid().sync();
            else xcd_barrier(xbar);
        }
    }
}

constexpr int NPHASES = 1 + 12 * NL;

extern "C" void kernel_launch(void* const* d_in, const int* in_sizes, int n_in, void* d_out, int out_size, void* d_ws, size_t ws_size, hipStream_t stream) {
    static int grid = 0;
    if (grid == 0) {
        if (n_in != 12 || in_sizes[0] != M * D || out_size != M * D || ws_size < WS_END) {
            fprintf(stderr, "kernel_launch: unexpected shapes: n_in %d in0 %d out %d ws %zu (need %zu)\n", n_in, n_in > 0 ? in_sizes[0] : -1, out_size, ws_size, (size_t)WS_END); grid = -1; return; }
        int dev = 0, cus = 0, per_cu = 0;
        hipGetDevice(&dev);
        hipDeviceGetAttribute(&cus, hipDeviceAttributeMultiprocessorCount, dev);
        if (hipFuncSetAttribute((const void*)fwd_kernel, hipFuncAttributeMaxDynamicSharedMemorySize, LDS_BYTES) != hipSuccess) { fprintf(stderr, "kernel_launch: hipFuncSetAttribute failed\n"); grid = -1; return; }
        if (hipOccupancyMaxActiveBlocksPerMultiprocessor(&per_cu, (const void*)fwd_kernel, NTHREADS, LDS_BYTES) != hipSuccess || per_cu < 1) { fprintf(stderr, "kernel_launch: occupancy query says %d\n", per_cu); per_cu = 1; }
        (void)hipGetLastError();
        grid = cus * 1;
        if (grid <= 0) grid = 256;
    }
    if (grid < 0) return;
    if (hipMemsetAsync((char*)d_ws + WS_BAR, 0, 16384, stream) != hipSuccess) { fprintf(stderr, "kernel_launch: memset failed\n"); return; }
    Args a{};
    for (int i = 0; i < 12; ++i) a.in[i] = (const float*)d_in[i];
    a.out = (float*)d_out; a.ws = (unsigned char*)d_ws;
#if ONE_LAUNCH
    a.ph_lo = 0; a.ph_hi = NPHASES;
    void* kargs[] = {&a};
    hipError_t e = hipLaunchCooperativeKernel((const void*)fwd_kernel, dim3(grid), dim3(NTHREADS), kargs, LDS_BYTES, stream);
    if (e != hipSuccess) fprintf(stderr, "kernel_launch: cooperative launch failed: %s (grid %d)\n", hipGetErrorString(e), grid);
#else
    for (int ph = 0; ph < NPHASES; ++ph) {
        a.ph_lo = ph; a.ph_hi = ph + 1;
        hipLaunchKernelGGL(fwd_kernel, dim3(grid), dim3(NTHREADS), LDS_BYTES, stream, a);
    }
#endif
}
```

```cpp
#include <hip/hip_runtime.h>
#include <hip/hip_cooperative_groups.h>
#include <cstdio>
#include <cstdint>
namespace cg = cooperative_groups;

#ifndef ONE_LAUNCH
#define ONE_LAUNCH 1
#endif

#ifndef D_PRO
#define D_PRO 1
#endif
#ifndef D_G1
#define D_G1 1
#endif
#ifndef D_G2
#define D_G2 1
#endif
#ifndef D_G3
#define D_G3 1
#endif
#ifndef D_M1
#define D_M1 1
#endif
#ifndef D_M2
#define D_M2 1
#endif
#ifndef D_AT
#define D_AT 1
#endif
#ifndef D_M3
#define D_M3 1
#endif
#ifndef PROBE_MASK
#define PROBE_MASK 0
#endif
#ifndef EN_ALL
#define EN_ALL 1
#endif
#ifndef EN_PRO
#define EN_PRO EN_ALL
#endif
#ifndef EN_G1
#define EN_G1 EN_ALL
#endif
#ifndef EN_G2
#define EN_G2 EN_ALL
#endif
#ifndef EN_N
#define EN_N EN_ALL
#endif
#ifndef EN_G3A
#define EN_G3A EN_ALL
#endif
#ifndef EN_G3B
#define EN_G3B EN_ALL
#endif
#ifndef EN_M1
#define EN_M1 EN_ALL
#endif
#ifndef EN_M2
#define EN_M2 EN_ALL
#endif
#ifndef EN_AT
#define EN_AT EN_ALL
#endif
#ifndef EN_M3
#define EN_M3 EN_ALL
#endif
#define LAS __attribute__((address_space(3)))
#define DI __device__ __forceinline__
typedef unsigned short bf16_t;
typedef short bf16x8 __attribute__((ext_vector_type(8)));
typedef float f32x4 __attribute__((ext_vector_type(4)));
typedef float f32x16 __attribute__((ext_vector_type(16)));
typedef unsigned u32x4 __attribute__((ext_vector_type(4)));
typedef unsigned u32x2 __attribute__((ext_vector_type(2)));
typedef __bf16 bf16x2_t __attribute__((ext_vector_type(2)));
typedef float f32x2_t __attribute__((ext_vector_type(2)));

constexpr int NB = 2, SEQ = 8192, M = NB * SEQ, D = 1024, DFF = 2816, NL = 2;
constexpr int MIXN = 3080;
constexpr float EPS = 1e-6f;
constexpr float LOG2E = 1.4426950408889634f;
constexpr float QSCALE = 0.125f * LOG2E;

constexpr size_t MiB = 1u << 20;
constexpr size_t WS_WIN = 0;
constexpr size_t WS_WOUT = 44 * MiB;
constexpr size_t WS_WMIXIN = 66 * MiB;
constexpr size_t WS_WMIXOUT = 78 * MiB;
constexpr size_t WS_GATES = 84 * MiB;
constexpr size_t WS_BCUM = WS_GATES + 512 * 1024;
constexpr size_t WS_LOGI = WS_BCUM + 256 * 1024;
constexpr size_t WS_NHAT = WS_LOGI + 256 * 1024;
constexpr size_t WS_NPREV = WS_NHAT + 256 * 1024;
constexpr size_t WS_CHS = WS_NPREV + 256 * 1024;
constexpr size_t WS_BAR = WS_CHS + 64 * 1024;
constexpr size_t WS_XN = 86 * MiB;
constexpr size_t WS_A = 118 * MiB;
constexpr size_t WS_Q = WS_A, WS_K = WS_A + 16 * MiB, WS_VTDA = WS_A + 32 * MiB, WS_VTML = WS_A + 48 * MiB, WS_MLO = WS_A + 64 * MiB, WS_QC = WS_A + 80 * MiB, WS_KC = WS_A + 88 * MiB;
constexpr size_t WS_Y = 214 * MiB;
constexpr size_t WS_MLQK = WS_Y, WS_CPREV = WS_Y, WS_UHAT = WS_Y + 32 * MiB;
constexpr size_t WS_END = 278 * MiB;

constexpr int LDS_BYTES = 147456;
constexpr int NTHREADS = 512;

DI unsigned pk2(float lo, float hi) { f32x2_t v = {lo, hi}; bf16x2_t b = __builtin_convertvector(v, bf16x2_t); return __builtin_bit_cast(unsigned, b); }
DI float bf_lo(unsigned u) { return __builtin_bit_cast(float, u << 16); }
DI float bf_hi(unsigned u) { return __builtin_bit_cast(float, u & 0xffff0000u); }
DI float dpp_f(float v, const int ctrl_sel) {
    const int x = __builtin_bit_cast(int, v);
    int r;
    if (ctrl_sel == 0) r = __builtin_amdgcn_update_dpp(0, x, 0xB1, 0xF, 0xF, true);
    else if (ctrl_sel == 1) r = __builtin_amdgcn_update_dpp(0, x, 0x4E, 0xF, 0xF, true);
    else if (ctrl_sel == 2) r = __builtin_amdgcn_update_dpp(0, x, 0x141, 0xF, 0xF, true);
    else r = __builtin_amdgcn_update_dpp(0, x, 0x140, 0xF, 0xF, true);
    return __builtin_bit_cast(float, r);
}
DI float wave_sum_dpp(float v) {
    v += dpp_f(v, 0); v += dpp_f(v, 1); v += dpp_f(v, 2); v += dpp_f(v, 3);
    { auto rr = __builtin_amdgcn_permlane16_swap(__builtin_bit_cast(unsigned, v), __builtin_bit_cast(unsigned, v), false, false);
      v = __builtin_bit_cast(float, (unsigned)rr[0]) + __builtin_bit_cast(float, (unsigned)rr[1]); }
    { auto rr = __builtin_amdgcn_permlane32_swap(__builtin_bit_cast(unsigned, v), __builtin_bit_cast(unsigned, v), false, false);
      v = __builtin_bit_cast(float, (unsigned)rr[0]) + __builtin_bit_cast(float, (unsigned)rr[1]); }
    return v;
}
DI float wave_max_dpp(float v) {
    v = fmaxf(v, dpp_f(v, 0)); v = fmaxf(v, dpp_f(v, 1)); v = fmaxf(v, dpp_f(v, 2)); v = fmaxf(v, dpp_f(v, 3));
    { auto rr = __builtin_amdgcn_permlane16_swap(__builtin_bit_cast(unsigned, v), __builtin_bit_cast(unsigned, v), false, false);
      v = fmaxf(__builtin_bit_cast(float, (unsigned)rr[0]), __builtin_bit_cast(float, (unsigned)rr[1])); }
    { auto rr = __builtin_amdgcn_permlane32_swap(__builtin_bit_cast(unsigned, v), __builtin_bit_cast(unsigned, v), false, false);
      v = fmaxf(__builtin_bit_cast(float, (unsigned)rr[0]), __builtin_bit_cast(float, (unsigned)rr[1])); }
    return v;
}
DI float half_sum(float v) { auto rr = __builtin_amdgcn_permlane32_swap(__builtin_bit_cast(unsigned, v), __builtin_bit_cast(unsigned, v), false, false);
    return __builtin_bit_cast(float, (unsigned)rr[0]) + __builtin_bit_cast(float, (unsigned)rr[1]); }
DI float half_max(float v) { auto rr = __builtin_amdgcn_permlane32_swap(__builtin_bit_cast(unsigned, v), __builtin_bit_cast(unsigned, v), false, false);
    return fmaxf(__builtin_bit_cast(float, (unsigned)rr[0]), __builtin_bit_cast(float, (unsigned)rr[1])); }
DI float shfl_from(float v, int src_lane) { return __builtin_bit_cast(float, __builtin_amdgcn_ds_bpermute(src_lane << 2, __builtin_bit_cast(int, v))); }
DI int crow(int reg, int h) { return (reg & 3) + 8 * (reg >> 2) + 4 * h; }
DI float max3f(float a, float b, float c) { float r; asm("v_max3_f32 %0, %1, %2, %3" : "=v"(r) : "v"(a), "v"(b), "v"(c)); return r; }
#define MFMA32(a, b, c) __builtin_amdgcn_mfma_f32_32x32x16_bf16((a), (b), (c), 0, 0, 0)

namespace pg8 {
constexpr int BM = 256, BK = 64, HALF = 128, HTB = HALF * BK * 2, STAGE_BYTES = 8 * HTB, NXCD = 8, WGM = 8;
DI int lds_byte(int r, int c) { const int st = (r >> 4) * 2 + (c >> 5), rr = r & 15, cc = c & 31, ob = rr * 64 + cc * 2; return st * 1024 + (ob ^ (((ob >> 9) & 1) << 5)); }
DI void stage_rc(int b, int& R, int& C) { const int st = b / 1024, sb = b % 1024, swz = sb ^ (((sb >> 9) & 1) << 5); R = (st >> 1) * 16 + swz / 64; C = (st & 1) * 32 + (swz % 64) / 2; }
DI int perm32(int rho) { const int n = rho >> 4, i = rho & 15; return 8 * (i >> 2) + 4 * n + (i & 3); }
struct Unit { int pm, pn; };
struct Gemm { const bf16_t* A; const bf16_t* Bt; int M, N, K; };
struct StaticOrder {
    int nM, nN, nwg, G, c;
    DI void init(int M_, int N_, int G_, int c_) { nM = M_ / BM; nN = N_ / BM; nwg = nM * nN; G = G_; c = c_; }
    DI bool next(int i, Unit& u) const {
        const long L = (long)i * G + c; if (L >= nwg) return false;
        int wgid = (int)L; { const int q = nwg / NXCD, r = nwg % NXCD, xcd = wgid % NXCD, off = wgid / NXCD; wgid = (xcd < r ? xcd * (q + 1) : r * (q + 1) + (xcd - r) * q) + off; }
        const int nig = WGM * nN, gid = wgid / nig, fm = gid * WGM, gsz = (nM - fm) < WGM ? (nM - fm) : WGM;
        u.pm = fm + ((wgid % nig) % gsz); u.pn = (wgid % nig) / gsz; return true;
    }
};

template <class Epi>
DI void gemm_phase(LAS unsigned char* lds, const int tid, const Gemm g, const StaticOrder& S, const Epi& E) {
    const int wid = __builtin_amdgcn_readfirstlane(tid >> 6), lane = tid & 63, wr = wid >> 2, wc = wid & 3, fr = lane & 15, fq = lane >> 4;
    const int K = g.K, nt = K / BK;
    unsigned voffA[2], voffB[2];
#pragma unroll
    for (int i = 0; i < 2; ++i) { int R, C; stage_rc(tid * 16 + i * 8192, R, C); const int Rb = Epi::PERM ? ((R & ~31) + perm32(R & 31)) : R;
        voffA[i] = (unsigned)(R * K + C) * 2u; voffB[i] = (unsigned)(Rb * K + C) * 2u; }
    const size_t kstep = (size_t)(BK * 2);
    const size_t hstep = (size_t)HALF * K * 2;
    const size_t tstep = 2 * hstep;
    const unsigned ldsw = (unsigned)wid * 1024u;
    const int aoff = lds_byte(wr * 64 + fr, fq * 8), boff = lds_byte(wc * 32 + fr, fq * 8);
#define PG8_SA(b, h) (((b) * 2 + (h)) * HTB)
#define PG8_SB(b, h) ((4 + (b) * 2 + (h)) * HTB)
#define PG8_STAGE(bufoff, gbase, voff) do { _Pragma("unroll") for (int _i = 0; _i < 2; ++_i) \
        __builtin_amdgcn_global_load_lds((const unsigned*)((const char*)(gbase) + (voff)[_i]), (LAS unsigned*)(lds + (bufoff) + ldsw + _i * 8192), 16, 0, 0); } while (0)
#define PG8_LDA(dst, b, h) do { _Pragma("unroll") for (int m = 0; m < 4; ++m) _Pragma("unroll") for (int k = 0; k < 2; ++k) dst[m][k] = *(const LAS bf16x8*)(lds + PG8_SA(b, h) + aoff + m * 2048 + k * 1024); } while (0)
#define PG8_LDB(dst, b, h) do { _Pragma("unroll") for (int n = 0; n < 2; ++n) _Pragma("unroll") for (int k = 0; k < 2; ++k) dst[n][k] = *(const LAS bf16x8*)(lds + PG8_SB(b, h) + boff + n * 2048 + k * 1024); } while (0)
#define PG8_MMA(ai, bj, At, Bt) do { __builtin_amdgcn_s_setprio(1); _Pragma("unroll") for (int m = 0; m < 4; ++m) _Pragma("unroll") for (int n = 0; n < 2; ++n) _Pragma("unroll") for (int k = 0; k < 2; ++k) \
        acc[ai][bj][m][n] = Epi::TRANS ? __builtin_amdgcn_mfma_f32_16x16x32_bf16(Bt[n][k], At[m][k], acc[ai][bj][m][n], 0, 0, 0) \
                                       : __builtin_amdgcn_mfma_f32_16x16x32_bf16(At[m][k], Bt[n][k], acc[ai][bj][m][n], 0, 0, 0); __builtin_amdgcn_s_setprio(0); } while (0)
#define PG8_WAIT_V(n) asm volatile("s_waitcnt vmcnt(" #n ")" ::: "memory")
#define PG8_WAIT_L(n) asm volatile("s_waitcnt lgkmcnt(" #n ")" ::: "memory")
#define PG8_BAR __builtin_amdgcn_s_barrier()
#define PG8_SCHED __builtin_amdgcn_sched_barrier(0)
    Unit cur, nxt; int ui = 0;
    if (!S.next(0, cur)) return;
    f32x4 acc[2][2][4][2];
#pragma unroll
    for (int a = 0; a < 2; ++a)
#pragma unroll
        for (int b = 0; b < 2; ++b)
#pragma unroll
            for (int m = 0; m < 4; ++m)
#pragma unroll
                for (int n = 0; n < 2; ++n) acc[a][b][m][n] = (f32x4){0.f, 0.f, 0.f, 0.f};
    bf16x8 At[4][2], B0[2][2], B1[2][2];
    const char* cA = (const char*)g.A + (size_t)cur.pm * tstep; const char* cB = (const char*)g.Bt + (size_t)cur.pn * tstep;
    PG8_STAGE(PG8_SB(0, 0), cB, voffB); PG8_STAGE(PG8_SB(0, 1), cB + hstep, voffB); PG8_STAGE(PG8_SA(0, 0), cA, voffA); PG8_STAGE(PG8_SA(0, 1), cA + hstep, voffA);
    if (wr == 1) PG8_BAR;
    PG8_WAIT_V(2); PG8_BAR;
    PG8_STAGE(PG8_SB(1, 0), cB + kstep, voffB); PG8_STAGE(PG8_SA(1, 0), cA + kstep, voffA); PG8_STAGE(PG8_SB(1, 1), cB + hstep + kstep, voffB);
    PG8_WAIT_V(6); PG8_BAR;
    for (;;) {
        const bool has_next = S.next(ui + 1, nxt);
        const char* nA = has_next ? (const char*)g.A + (size_t)nxt.pm * tstep : cA; const char* nB = has_next ? (const char*)g.Bt + (size_t)nxt.pn * tstep : cB;
        for (int t = 0; t < nt; t += 2) {
            const bool last = (t == nt - 2);
            const char* a1 = cA + (size_t)(t + 1) * kstep;
            const char* a2 = last ? nA : cA + (size_t)(t + 2) * kstep; const char* b2 = last ? nB : cB + (size_t)(t + 2) * kstep;
            const char* a3 = a2 + kstep; const char* b3 = b2 + kstep;
            PG8_LDB(B0, 0, 0); PG8_LDB(B1, 0, 1); PG8_SCHED; PG8_LDA(At, 0, 0); PG8_STAGE(PG8_SA(1, 1), a1 + hstep, voffA);
            PG8_WAIT_V(8); PG8_WAIT_L(0); PG8_BAR; PG8_MMA(0, 0, At, B0); PG8_MMA(0, 1, At, B1); PG8_BAR; PG8_SCHED;
            PG8_LDA(At, 0, 1); PG8_STAGE(PG8_SB(0, 0), b2, voffB); PG8_STAGE(PG8_SB(0, 1), b2 + hstep, voffB); PG8_STAGE(PG8_SA(0, 0), a2, voffA);
            PG8_WAIT_V(8); PG8_WAIT_L(0); PG8_BAR; PG8_MMA(1, 0, At, B0); PG8_MMA(1, 1, At, B1); PG8_BAR; PG8_SCHED;
            PG8_LDB(B0, 1, 0); PG8_LDB(B1, 1, 1); PG8_SCHED; PG8_LDA(At, 1, 0); PG8_STAGE(PG8_SA(0, 1), a2 + hstep, voffA);
            PG8_WAIT_V(8); PG8_WAIT_L(0); PG8_BAR; PG8_MMA(0, 0, At, B0); PG8_MMA(0, 1, At, B1); PG8_BAR; PG8_SCHED;
            PG8_LDA(At, 1, 1); PG8_STAGE(PG8_SB(1, 0), b3, voffB); PG8_STAGE(PG8_SB(1, 1), b3 + hstep, voffB); PG8_STAGE(PG8_SA(1, 0), a3, voffA);
            PG8_WAIT_V(8); PG8_WAIT_L(0); PG8_BAR; PG8_MMA(1, 0, At, B0); PG8_MMA(1, 1, At, B1); PG8_BAR; PG8_SCHED;
        }
        if (wr == 0) PG8_BAR;
        E(acc, cur, wr, wc, fr, fq);
        if (!has_next) break;
#pragma unroll
        for (int a = 0; a < 2; ++a)
#pragma unroll
            for (int b = 0; b < 2; ++b)
#pragma unroll
                for (int m = 0; m < 4; ++m)
#pragma unroll
                    for (int n = 0; n < 2; ++n) acc[a][b][m][n] = (f32x4){0.f, 0.f, 0.f, 0.f};
        cur = nxt; cA = nA; cB = nB; ++ui;
        if (wr == 1) PG8_BAR;
    }
    PG8_WAIT_V(0);
    PG8_BAR;
#undef PG8_SA
#undef PG8_SB
#undef PG8_STAGE
#undef PG8_LDA
#undef PG8_LDB
#undef PG8_MMA
#undef PG8_WAIT_V
#undef PG8_WAIT_L
#undef PG8_BAR
#undef PG8_SCHED
}

DI float silu_mul(float g, float u) { return g * __builtin_amdgcn_rcpf(1.f + __builtin_amdgcn_exp2f(-g * LOG2E)) * u; }

struct EpiSwiglu {
    static constexpr bool PERM = true, TRANS = true;
    bf16_t* O;
    DI void operator()(const f32x4 (&acc)[2][2][4][2], const Unit& u, int wr, int wc, int fr, int fq) const {
        const int row0 = u.pm * BM + wr * 64 + fr, col0 = u.pn * 128 + wc * 32 + 8 * fq;
#pragma unroll
        for (int ai = 0; ai < 2; ++ai)
#pragma unroll
            for (int m = 0; m < 4; ++m) {
                const f32x4 g0 = acc[ai][0][m][0], g1 = acc[ai][0][m][1], u0 = acc[ai][1][m][0], u1 = acc[ai][1][m][1];
                u32x4 w;
                w.x = pk2(silu_mul(g0[0], u0[0]), silu_mul(g0[1], u0[1])); w.y = pk2(silu_mul(g0[2], u0[2]), silu_mul(g0[3], u0[3]));
                w.z = pk2(silu_mul(g1[0], u1[0]), silu_mul(g1[1], u1[1])); w.w = pk2(silu_mul(g1[2], u1[2]), silu_mul(g1[3], u1[3]));
                *(u32x4*)(O + (size_t)(row0 + ai * HALF + m * 16) * DFF + col0) = w;
            }
    }
};

struct EpiBf16 {
    static constexpr bool PERM = true, TRANS = true;
    bf16_t* O; int ldc;
    DI void operator()(const f32x4 (&acc)[2][2][4][2], const Unit& u, int wr, int wc, int fr, int fq) const {
        const int row0 = u.pm * BM + wr * 64 + fr, col0 = u.pn * BM + wc * 32 + 8 * fq;
#pragma unroll
        for (int ai = 0; ai < 2; ++ai)
#pragma unroll
            for (int m = 0; m < 4; ++m) {
                bf16_t* rowp = O + (size_t)(row0 + ai * HALF + m * 16) * ldc + col0;
#pragma unroll
                for (int bj = 0; bj < 2; ++bj) { const f32x4 v0 = acc[ai][bj][m][0], v1 = acc[ai][bj][m][1];
                    u32x4 w; w.x = pk2(v0[0], v0[1]); w.y = pk2(v0[2], v0[3]); w.z = pk2(v1[0], v1[1]); w.w = pk2(v1[2], v1[3]);
                    *(u32x4*)(rowp + bj * HALF) = w; }
            }
    }
};

struct EpiMix {
    static constexpr bool PERM = true, TRANS = true;
    bf16_t* Q; bf16_t* Kd; bf16_t* MLQK; bf16_t* MLO;
    DI void operator()(const f32x4 (&acc)[2][2][4][2], const Unit& u, int wr, int wc, int fr, int fq) const {
        const int row0 = u.pm * BM + wr * 64 + fr; const int pn = u.pn;
        if (pn < 4) {
            bf16_t* dst = (pn < 2) ? Q : Kd; const float sc = (pn < 2) ? QSCALE : 1.f;
            const int G = (pn & 1) * 4 + wc, head = G >> 1, c = G & 1;
            float ifr[8];
#pragma unroll
            for (int j = 0; j < 8; ++j) ifr[j] = __builtin_amdgcn_exp2f(-(float)(2 * (8 * fq + j)) * (13.287712379549449f / 64.f));
#pragma unroll
            for (int ai = 0; ai < 2; ++ai)
#pragma unroll
                for (int m = 0; m < 4; ++m) {
                    const int row = row0 + ai * HALF + m * 16, b = row >> 13, s = row & (SEQ - 1);
                    const float sf = (float)s;
                    float cs[8], sn[8];
#pragma unroll
                    for (int j = 0; j < 8; ++j) { float rev = (sf * ifr[j]) * 0.15915494309189535f; rev = __builtin_amdgcn_fractf(rev); cs[j] = __builtin_amdgcn_cosf(rev); sn[j] = __builtin_amdgcn_sinf(rev); }
                    const f32x4 r0 = {cs[0], sn[0], cs[1], sn[1]}, r1 = {cs[2], sn[2], cs[3], sn[3]}, r2 = {cs[4], sn[4], cs[5], sn[5]}, r3 = {cs[6], sn[6], cs[7], sn[7]};
                    const f32x4 a0 = acc[ai][0][m][0], a1 = acc[ai][0][m][1], b0 = acc[ai][1][m][0], b1 = acc[ai][1][m][1];
                    u32x4 w1, w2;
                    w1.x = pk2((a0[0] * r0[0] - b0[0] * r0[1]) * sc, (a0[1] * r0[2] - b0[1] * r0[3]) * sc);
                    w1.y = pk2((a0[2] * r1[0] - b0[2] * r1[1]) * sc, (a0[3] * r1[2] - b0[3] * r1[3]) * sc);
                    w1.z = pk2((a1[0] * r2[0] - b1[0] * r2[1]) * sc, (a1[1] * r2[2] - b1[1] * r2[3]) * sc);
                    w1.w = pk2((a1[2] * r3[0] - b1[2] * r3[1]) * sc, (a1[3] * r3[2] - b1[3] * r3[3]) * sc);
                    w2.x = pk2((b0[0] * r0[0] + a0[0] * r0[1]) * sc, (b0[1] * r0[2] + a0[1] * r0[3]) * sc);
                    w2.y = pk2((b0[2] * r1[0] + a0[2] * r1[1]) * sc, (b0[3] * r1[2] + a0[3] * r1[3]) * sc);
                    w2.z = pk2((b1[0] * r2[0] + a1[0] * r2[1]) * sc, (b1[1] * r2[2] + a1[1] * r2[3]) * sc);
                    w2.w = pk2((b1[2] * r3[0] + a1[2] * r3[1]) * sc, (b1[3] * r3[2] + a1[3] * r3[3]) * sc);
                    bf16_t* base = dst + ((size_t)(((b * 4 + head) * 2 + c) * SEQ + s)) * 64 + 8 * fq;
                    *(u32x4*)base = w1; *(u32x4*)(base + 32) = w2;
                }
        } else if (pn < 6) {
            const int col0 = (pn - 4) * BM + wc * 32 + 8 * fq;
#pragma unroll
            for (int ai = 0; ai < 2; ++ai)
#pragma unroll
                for (int m = 0; m < 4; ++m) {
                    bf16_t* rowp = MLQK + (size_t)(row0 + ai * HALF + m * 16) * 512 + col0;
#pragma unroll
                    for (int bj = 0; bj < 2; ++bj) { const f32x4 v0 = acc[ai][bj][m][0], v1 = acc[ai][bj][m][1];
                        u32x4 w; w.x = pk2(v0[0], v0[1]); w.y = pk2(v0[2], v0[3]); w.z = pk2(v1[0], v1[1]); w.w = pk2(v1[2], v1[3]);
                        *(u32x4*)(rowp + bj * HALF) = w; }
                }
        } else {
            const int col0 = (pn - 6) * BM + wc * 32 + 8 * fq;
#pragma unroll
            for (int ai = 0; ai < 2; ++ai)
#pragma unroll
                for (int m = 0; m < 4; ++m) {
                    bf16_t* rowp = MLO + (size_t)(row0 + ai * HALF + m * 16) * 512 + col0;
#pragma unroll
                    for (int bj = 0; bj < 2; ++bj) { const f32x4 v0 = acc[ai][bj][m][0], v1 = acc[ai][bj][m][1];
                        u32x4 w; w.x = pk2(v0[0], v0[1]); w.y = pk2(v0[2], v0[3]); w.z = pk2(v1[0], v1[1]); w.w = pk2(v1[2], v1[3]);
                        *(u32x4*)(rowp + bj * HALF) = w; }
                }
        }
    }
};

struct EpiVT {
    static constexpr bool PERM = false, TRANS = false;
    bf16_t* VTda; bf16_t* VTml;
    DI void operator()(const f32x4 (&acc)[2][2][4][2], const Unit& u, int wr, int wc, int fr, int fq) const {
        bf16_t* dst = (u.pn < 2) ? VTda : VTml;
#pragma unroll
        for (int ai = 0; ai < 2; ++ai)
#pragma unroll
            for (int m = 0; m < 4; ++m) {
                const int row = u.pm * BM + ai * HALF + wr * 64 + m * 16 + 4 * fq, b = row >> 13, s = row & (SEQ - 1);
#pragma unroll
                for (int bj = 0; bj < 2; ++bj)
#pragma unroll
                    for (int n = 0; n < 2; ++n) {
                        const int head = (u.pn & 1) * 2 + bj, d = wc * 32 + n * 16 + fr;
                        const f32x4 v = acc[ai][bj][m][n];
                        u32x2 w; w.x = pk2(v[0], v[1]); w.y = pk2(v[2], v[3]);
                        *(u32x2*)(dst + ((size_t)((b * 4 + head) * 128 + d)) * SEQ + s) = w;
                    }
            }
    }
};
}

struct Args { const float* in[12]; float* out; unsigned char* ws; int ph_lo, ph_hi; };

struct Ctx {
    LAS unsigned char* lds;
    int tid, lane, wave, bid, G;
    const float *x, *ffn_w_in, *ffn_w_out, *norm_g, *mix_w_in, *mix_w_out, *da_lambda, *da_subln_g, *conv_w, *conv_b, *gate_b, *ml_norm_g;
    float* out; unsigned char* ws;
};

DI void transpose_item(const float* W, int N, int K, int k0, int src_n0, bf16_t* WT, int dst_row0, LAS float* scr, int lane) {
    const int kr = lane >> 3, n4 = (lane & 7) * 4;
    f32x4 v[8];
#pragma unroll
    for (int i = 0; i < 8; ++i) v[i] = *(const f32x4*)(W + (size_t)(k0 + kr + 8 * i) * N + src_n0 + n4);
#pragma unroll
    for (int i = 0; i < 8; ++i) { LAS float* p = scr + (kr + 8 * i) * 33 + n4; p[0] = v[i][0]; p[1] = v[i][1]; p[2] = v[i][2]; p[3] = v[i][3]; }
    asm volatile("s_waitcnt lgkmcnt(0)" ::: "memory");
    const int c = lane & 7;
#pragma unroll
    for (int j = 0; j < 4; ++j) { const int n = (lane >> 3) + 8 * j; const LAS float* s = scr + (8 * c) * 33 + n;
        u32x4 o; o.x = pk2(s[0 * 33], s[1 * 33]); o.y = pk2(s[2 * 33], s[3 * 33]); o.z = pk2(s[4 * 33], s[5 * 33]); o.w = pk2(s[6 * 33], s[7 * 33]);
        *(u32x4*)(WT + (size_t)(dst_row0 + n) * K + k0 + 8 * c) = o; }
    asm volatile("s_waitcnt lgkmcnt(0)" ::: "memory");
}

DI void norm_phase(const Ctx& F, const float* xsrc, float* xdst, const bf16_t* Y, const float* gpost, float coef, const float* gpre, bf16_t* XN,
                   const float* Wg, const float* gate_b, float* gates) {
    LAS float* wgT = (LAS float*)F.lds;
    if (Wg) {
        for (int i = F.tid; i < 1024 * 8; i += NTHREADS) wgT[(i & 7) * 1024 + (i >> 3)] = Wg[(size_t)(i >> 3) * MIXN + (i & 7)];
        __syncthreads();
    }
    const int gw = F.bid * 8 + F.wave, NGW = F.G * 8, lane = F.lane;
    f32x4 gpo[4], gpr[4];
#pragma unroll
    for (int j = 0; j < 4; ++j) { gpo[j] = Y ? ((const f32x4*)gpost)[64 * j + lane] * coef : (f32x4){0.f, 0.f, 0.f, 0.f}; gpr[j] = gpre ? ((const f32x4*)gpre)[64 * j + lane] : (f32x4){0.f, 0.f, 0.f, 0.f}; }
    f32x4 gb0 = {0.f, 0.f, 0.f, 0.f}, gb1 = {0.f, 0.f, 0.f, 0.f};
    if (Wg) { gb0 = *(const f32x4*)gate_b; gb1 = *(const f32x4*)(gate_b + 4); }
    constexpr int NR = 2;
    for (int row0 = gw; row0 < M; row0 += NGW * NR) {
        f32x4 v[NR][4]; u32x2 y[NR][4];
#pragma unroll
        for (int r = 0; r < NR; ++r) {
            const int row = row0 + NGW * r, rowc = row < M ? row : row0;
            const f32x4* xr = (const f32x4*)(xsrc + (size_t)rowc * D) + lane;
#pragma unroll
            for (int j = 0; j < 4; ++j) v[r][j] = __builtin_nontemporal_load(xr + 64 * j);
            if (Y) { const u32x2* yr = (const u32x2*)(Y + (size_t)rowc * D) + lane;
#pragma unroll
                for (int j = 0; j < 4; ++j) y[r][j] = __builtin_nontemporal_load(yr + 64 * j); }
            else {
#pragma unroll
                for (int j = 0; j < 4; ++j) y[r][j] = (u32x2){0u, 0u}; }
        }
#pragma unroll
        for (int r = 0; r < NR; ++r) {
            const int row = row0 + NGW * r;
            if (row < M) {
                if (Y) {
                    f32x4 yf[4]; float s = 0.f;
#pragma unroll
                    for (int j = 0; j < 4; ++j) { yf[j] = (f32x4){bf_lo(y[r][j].x), bf_hi(y[r][j].x), bf_lo(y[r][j].y), bf_hi(y[r][j].y)}; s += (yf[j][0] * yf[j][0] + yf[j][1] * yf[j][1]) + (yf[j][2] * yf[j][2] + yf[j][3] * yf[j][3]); }
                    const float rstd = 1.f / sqrtf(wave_sum_dpp(s) * (1.f / D) + EPS);
                    f32x4* xo = (f32x4*)(xdst + (size_t)row * D) + lane;
#pragma unroll
                    for (int j = 0; j < 4; ++j) { v[r][j] = v[r][j] + yf[j] * gpo[j] * rstd; xo[64 * j] = v[r][j]; }
                }
                if (gpre) {
                    float s = 0.f;
#pragma unroll
                    for (int j = 0; j < 4; ++j) s += (v[r][j][0] * v[r][j][0] + v[r][j][1] * v[r][j][1]) + (v[r][j][2] * v[r][j][2] + v[r][j][3] * v[r][j][3]);
                    const float rstd = 1.f / sqrtf(wave_sum_dpp(s) * (1.f / D) + EPS);
                    u32x2* o8 = (u32x2*)(XN + (size_t)row * D) + lane;
#pragma unroll
                    for (int j = 0; j < 4; ++j) { v[r][j] = v[r][j] * gpr[j] * rstd; u32x2 w; w.x = pk2(v[r][j][0], v[r][j][1]); w.y = pk2(v[r][j][2], v[r][j][3]); o8[64 * j] = w; }
                    if (Wg) {
                        float ga[8];
#pragma unroll
                        for (int g = 0; g < 8; ++g) {
                            float a = 0.f;
#pragma unroll
                            for (int j = 0; j < 4; ++j) { const f32x4 w4 = *(const LAS f32x4*)(wgT + g * 1024 + 256 * j + 4 * lane); a += (w4[0] * v[r][j][0] + w4[1] * v[r][j][1]) + (w4[2] * v[r][j][2] + w4[3] * v[r][j][3]); }
                            ga[g] = wave_sum_dpp(a);
                        }
                        if (lane == 0) {
                            f32x4 o0 = {ga[0] + gb0[0], ga[1] + gb0[1], ga[2] + gb0[2], ga[3] + gb0[3]}, o1 = {ga[4] + gb1[0], ga[5] + gb1[1], ga[6] + gb1[2], ga[7] + gb1[3]};
                            *(f32x4*)(gates + (size_t)row * 8) = o0; *(f32x4*)(gates + (size_t)row * 8 + 4) = o1;
                        }
                    }
                }
            }
        }
    }
    if (Wg) __syncthreads();
}

constexpr int I_IN = 16 * 176, I_OUT = 44 * 32, I_MI = 16 * 96, I_MO = 16 * 32;
DI void conv_one(const Ctx& F, int type, int mi, int r, LAS float* scr) {
    const int lane = F.lane;
    if (type == 0) {
        const int kb = r / 176, nb = r % 176, np = 32 * nb, pn = np >> 8, j = np & 255, bj = j >> 7, jj = j & 127;
        transpose_item(F.ffn_w_in + (size_t)mi * D * 2 * DFF, 2 * DFF, D, 64 * kb, bj * DFF + 128 * pn + jj, (bf16_t*)(F.ws + WS_WIN) + (size_t)mi * 2 * DFF * D, np, scr, lane);
    } else if (type == 1) {
        const int kb = r / 32, nb = r % 32;
        transpose_item(F.ffn_w_out + (size_t)mi * DFF * D, D, DFF, 64 * kb, 32 * nb, (bf16_t*)(F.ws + WS_WOUT) + (size_t)mi * D * DFF, 32 * nb, scr, lane);
    } else if (type == 2) {
        const int kb = r / 96, nb = r % 96, np = 32 * nb, region = np >> 9, off = np & 511;
        int src;
        if (region < 2) { const int j = np & 255, bj = j >> 7, jj = j & 127, grp = jj >> 5; src = (np - j) + grp * 64 + bj * 32; }
        else if (region == 2) src = 1536 + off;
        else if (region == 3) src = 2560 + off;
        else if (region == 4) src = 1024 + off;
        else src = 2048 + off;
        transpose_item(F.mix_w_in + (size_t)mi * D * MIXN, MIXN, D, 64 * kb, src, (bf16_t*)(F.ws + WS_WMIXIN) + (size_t)mi * 3072 * D, np, scr, lane);
    } else {
        const int kb = r / 32, nb = r % 32;
        transpose_item(F.mix_w_out + (size_t)mi * D * D, D, D, 64 * kb, 32 * nb, (bf16_t*)(F.ws + WS_WMIXOUT) + (size_t)mi * D * D, 32 * nb, scr, lane);
    }
}
template <int GRP> DI void conv_group(const Ctx& F, int worker, int nworkers, LAS float* scr) {
    constexpr int NSEG = GRP == 0 ? 2 : (GRP == 3 ? 2 : 4);
    constexpr int types[4][4] = {{0, 1, 0, 0}, {2, 3, 0, 1}, {0, 1, 2, 3}, {0, 1, 0, 0}};
    constexpr int idxs[4][4] = {{0, 0, 0, 0}, {0, 0, 1, 1}, {2, 2, 1, 1}, {3, 3, 0, 0}};
    constexpr int cnt[4] = {I_IN, I_OUT, I_MI, I_MO};
    int total = 0;
#pragma unroll
    for (int sg = 0; sg < NSEG; ++sg) total += cnt[types[GRP][sg]];
    for (int it = worker; it < total; it += nworkers) {
        int r = it;
#pragma unroll
        for (int sg = 0; sg < NSEG; ++sg) {
            const int n = cnt[types[GRP][sg]];
            if (r >= 0 && r < n) conv_one(F, types[GRP][sg], idxs[GRP][sg], r, scr);
            r -= n;
        }
    }
}

DI void prologue(const Ctx& F) {
    LAS float* scr = (LAS float*)(F.lds + F.wave * 16384);
    const int gw = F.bid * 8 + F.wave, NGW = F.G * 8, lane = F.lane;
    conv_group<0>(F, gw, NGW, scr);
    norm_phase(F, F.x, nullptr, nullptr, nullptr, 0.f, F.norm_g, (bf16_t*)(F.ws + WS_XN), nullptr, nullptr, nullptr);
}

DI float silu_f(float v) { return v / (1.f + __expf(-v)); }
DI bf16x8 ld_bf16x8_g(const bf16_t* p) { return *(const bf16x8*)p; }

DI void m1_phase(const Ctx& F, int l) {
    const int tid = F.tid, lane = F.lane, wave = F.wave;
    LAS bf16_t* KW = (LAS bf16_t*)F.lds;
    LAS float* wl = (LAS float*)(F.lds + 9216);
    const bf16_t* MLQK = (const bf16_t*)(F.ws + WS_MLQK);
    const float* gates = (const float*)(F.ws + WS_GATES);
    const bf16_t* VT = (const bf16_t*)(F.ws + WS_VTML);
    float* UHAT = (float*)(F.ws + WS_UHAT); float* NHAT = (float*)(F.ws + WS_NHAT);
    float* BCUM = (float*)(F.ws + WS_BCUM); float* LOGI = (float*)(F.ws + WS_LOGI);
    float* CHS = (float*)(F.ws + WS_CHS);
    bf16_t* QC = (bf16_t*)(F.ws + WS_QC); bf16_t* KC = (bf16_t*)(F.ws + WS_KC);
    LAS float* cw = (LAS float*)(F.lds + 16384); LAS float* cb = cw + 2048;
    for (int i = tid; i < 2560; i += NTHREADS) cw[i] = (i < 2048) ? F.conv_w[(size_t)l * 2048 + i] : F.conv_b[(size_t)l * 512 + (i - 2048)];
    __syncthreads();
    const int tl = tid >> 3, d0 = (tid & 7) * 8, r = lane & 31, hh = lane >> 5;
    float gi = 0.f, gf = 0.f; u32x4 xin[2][4];
#define M1_ISSUE(U) do { const int bh_ = (U) & 7, c_ = (U) >> 3, b_ = bh_ >> 2, h_ = bh_ & 3, s0_ = c_ * 64, tok0_ = b_ * SEQ + s0_; \
        gi = gates[(size_t)(tok0_ + lane) * 8 + h_]; gf = gates[(size_t)(tok0_ + lane) * 8 + 4 + h_]; \
        _Pragma("unroll") for (int which = 0; which < 2; ++which) _Pragma("unroll") for (int j = 0; j < 4; ++j) { const int s_ = s0_ + tl - 3 + j; \
            xin[which][j] = *(const u32x4*)(MLQK + (size_t)(b_ * SEQ + (s_ < 0 ? 0 : s_)) * 512 + which * 256 + h_ * 64 + d0); } } while (0)
    if (F.bid < 1024) M1_ISSUE(F.bid);
    for (int unit = F.bid; unit < 1024; unit += F.G) {
        const int bh = unit & 7, c = unit >> 3, b = bh >> 2, h = bh & 3, s0 = c * 64, tok0 = b * SEQ + s0;
        bf16x8 vfr[4];
        { const bf16_t* ap = VT + ((size_t)(bh * 128 + 32 * (wave >> 1) + r)) * SEQ + s0 + 8 * hh;
#pragma unroll
          for (int ks = 0; ks < 4; ++ks) vfr[ks] = *(const bf16x8*)(ap + 16 * ks); }
        if (wave == 0) {
            const float lf = fminf(gf, 0.f) - log1pf(__expf(-fabsf(gf)));
            float bc = lf;
#pragma unroll
            for (int o = 1; o < 64; o <<= 1) { const float t = shfl_from(bc, (lane - o) & 63); if (lane >= o) bc += t; }
            const float bl = shfl_from(bc, 63);
            const float a = bl - bc + gi;
            const float amax = wave_max_dpp(a);
            wl[lane] = __expf(a - amax);
            BCUM[bh * SEQ + s0 + lane] = bc; LOGI[bh * SEQ + s0 + lane] = gi;
            if (lane == 0) { CHS[bh * 128 + c] = bl; CHS[1024 + bh * 128 + c] = amax; }
        }
        float kv[8];
#pragma unroll
        for (int which = 0; which < 2; ++which) {
            const int ch = which * 256 + h * 64 + d0;
            float a8[8];
            { const f32x4 b0 = *(const LAS f32x4*)(cb + ch), b1 = *(const LAS f32x4*)(cb + ch + 4);
              a8[0] = b0[0]; a8[1] = b0[1]; a8[2] = b0[2]; a8[3] = b0[3]; a8[4] = b1[0]; a8[5] = b1[1]; a8[6] = b1[2]; a8[7] = b1[3]; }
#pragma unroll
            for (int j = 0; j < 4; ++j) {
                const float keep = (s0 + tl - 3 + j >= 0) ? 1.f : 0.f;
                const u32x4 xb = xin[which][j]; const f32x4 x0 = {bf_lo(xb.x), bf_hi(xb.x), bf_lo(xb.y), bf_hi(xb.y)}, x1 = {bf_lo(xb.z), bf_hi(xb.z), bf_lo(xb.w), bf_hi(xb.w)};
                const f32x4 w0 = *(const LAS f32x4*)(cw + j * 512 + ch) * keep, w1 = *(const LAS f32x4*)(cw + j * 512 + ch + 4) * keep;
                a8[0] += w0[0] * x0[0]; a8[1] += w0[1] * x0[1]; a8[2] += w0[2] * x0[2]; a8[3] += w0[3] * x0[3];
                a8[4] += w1[0] * x1[0]; a8[5] += w1[1] * x1[1]; a8[6] += w1[2] * x1[2]; a8[7] += w1[3] * x1[3];
            }
            const float sc = which == 0 ? 0.125f : 1.f;
#pragma unroll
            for (int i = 0; i < 8; ++i) a8[i] = silu_f(a8[i]) * sc;
            u32x4 w; w.x = pk2(a8[0], a8[1]); w.y = pk2(a8[2], a8[3]); w.z = pk2(a8[4], a8[5]); w.w = pk2(a8[6], a8[7]);
            bf16_t* dst = (which == 0 ? QC : KC) + ((size_t)bh * SEQ + s0 + tl) * 64 + d0;
            *(u32x4*)dst = w;
            if (which == 1) {
#pragma unroll
                for (int i = 0; i < 8; ++i) kv[i] = a8[i];
            }
        }
        if (unit + F.G < 1024) M1_ISSUE(unit + F.G);
        __syncthreads();
        { const float wt = wl[tl];
#pragma unroll
          for (int i = 0; i < 8; ++i) { const unsigned p = pk2(wt * kv[i], 0.f); KW[(d0 + i) * 72 + tl] = (bf16_t)(p & 0xffffu); } }
        __syncthreads();
        { const int et = wave >> 1, dt = wave & 1;
          f32x16 acc;
#pragma unroll
          for (int i = 0; i < 16; ++i) acc[i] = 0.f;
          const LAS bf16_t* bp = KW + (32 * dt + r) * 72 + 8 * hh;
#pragma unroll
          for (int ks = 0; ks < 4; ++ks) { const bf16x8 bb = *(const LAS bf16x8*)(bp + 16 * ks); acc = MFMA32(vfr[ks], bb, acc); }
          float* up = UHAT + ((size_t)(bh * 128 + c) * 128 + 32 * et) * 64 + 32 * dt + r;
#pragma unroll
          for (int i = 0; i < 16; ++i) up[crow(i, hh) * 64] = acc[i];
        }
        if (tid < 64) {
            float s = 0.f;
#pragma unroll
            for (int q8 = 0; q8 < 8; ++q8) { const u32x4 v = *(const LAS u32x4*)(KW + tid * 72 + 8 * q8);
                s += (bf_lo(v.x) + bf_hi(v.x)) + (bf_lo(v.y) + bf_hi(v.y)) + (bf_lo(v.z) + bf_hi(v.z)) + (bf_lo(v.w) + bf_hi(v.w)); }
            NHAT[(size_t)(bh * 128 + c) * 64 + tid] = s;
        }
        __syncthreads();
    }
}

#undef M1_ISSUE
DI void m2_phase(const Ctx& F, int l) {
    const float* UHAT = (const float*)(F.ws + WS_UHAT); const float* NHAT = (const float*)(F.ws + WS_NHAT);
    bf16_t* CPREV = (bf16_t*)(F.ws + WS_CPREV); float* NPREV = (float*)(F.ws + WS_NPREV);
    float* CHS = (float*)(F.ws + WS_CHS);
    LAS float* sco = (LAS float*)F.lds;
    for (int i = F.tid; i < 2048; i += NTHREADS) sco[i] = CHS[i];
    __syncthreads();
    for (int idx = (F.wave * F.G + F.bid) * 64 + F.lane; idx < 8 * 8256; idx += F.G * NTHREADS) {
        const int bh = idx / 8256, e = idx - bh * 8256;
        const float* __restrict__ src; float* __restrict__ dst = nullptr; bf16_t* __restrict__ dst16 = nullptr; int stride;
        if (e < 8192) { src = UHAT + (size_t)bh * 128 * 8192 + e; dst16 = CPREV + (size_t)bh * 128 * 8192 + e; stride = 8192; }
        else { src = NHAT + (size_t)bh * 128 * 64 + (e - 8192); dst = NPREV + (size_t)bh * 128 * 64 + (e - 8192); stride = 64; }
        const LAS float* bl = sco + bh * 128; const LAS float* am = sco + 1024 + bh * 128; float* mp = CHS + 2048 + bh * 128;
        float m = 0.f, C = 0.f;
        for (int c = 0; c < 128; c += 32) {
            float u[32];
#pragma unroll
            for (int i = 0; i < 32; ++i) u[i] = __builtin_nontemporal_load(src + (size_t)(c + i) * stride);
#pragma unroll
            for (int i = 0; i < 32; ++i) {
                if (dst16) dst16[(size_t)(c + i) * stride] = (bf16_t)(pk2(C, 0.f) & 0xffffu); else dst[(size_t)(c + i) * stride] = C;
                if (e == 0) mp[c + i] = m;
                const float blc = bl[c + i], amc = am[c + i];
                const float mn = fmaxf(blc + m, amc);
                C = __expf(blc + m - mn) * C + __expf(amc - mn) * u[i];
                m = mn;
            }
        }
    }
}

DI void m3_phase(const Ctx& F, int l) {
    int tid = F.tid; asm volatile("" : "+v"(tid));
    const int lane = tid & 63, wave = F.wave;
    LAS unsigned char* L = F.lds;
    LAS bf16_t* Qs = (LAS bf16_t*)(L + 0); LAS bf16_t* Ks = (LAS bf16_t*)(L + 9216); LAS bf16_t* VTs = (LAS bf16_t*)(L + 18432); LAS bf16_t* Cs = (LAS bf16_t*)(L + 36864);
    LAS bf16_t* Ws = (LAS bf16_t*)(L + 55296); LAS bf16_t* Qds = (LAS bf16_t*)(L + 64512); LAS float* Hs = (LAS float*)(L + 73728);
    LAS float* vu = (LAS float*)(L + 107520); LAS float* vmm = vu + 64; LAS float* vdec = vu + 128; LAS float* vem = vu + 192; LAS float* vnp = vu + 256; LAS float* vhd = vu + 320;
    const bf16_t* QC = (const bf16_t*)(F.ws + WS_QC); const bf16_t* KC = (const bf16_t*)(F.ws + WS_KC);
    const bf16_t* VT = (const bf16_t*)(F.ws + WS_VTML); const bf16_t* MLO = (const bf16_t*)(F.ws + WS_MLO);
    const bf16_t* CPREV = (const bf16_t*)(F.ws + WS_CPREV); const float* NPREV = (const float*)(F.ws + WS_NPREV);
    const float* BCUM = (const float*)(F.ws + WS_BCUM); const float* LOGI = (const float*)(F.ws + WS_LOGI); const float* CHS = (const float*)(F.ws + WS_CHS);
    bf16_t* YMIX = (bf16_t*)(F.ws + WS_XN);
    LAS float* ng = vu + 384;
    if (tid < 128) ng[tid] = F.ml_norm_g[(size_t)l * 128 + tid];
    __syncthreads();
    const int tl = tid >> 3, d0 = (tid & 7) * 8, r = lane & 31, hh = lane >> 5;
    u32x4 gq, gk, gv[2], gc[2]; float bs = 0.f, li = 0.f, mprev = 0.f, npv = 0.f;
#define M3_ISSUE(U) do { const int bh_ = (U) & 7, c_ = (U) >> 3, s0_ = c_ * 64; \
        gq = __builtin_nontemporal_load((const u32x4*)(QC + ((size_t)bh_ * SEQ + s0_ + tl) * 64 + d0)); gk = __builtin_nontemporal_load((const u32x4*)(KC + ((size_t)bh_ * SEQ + s0_ + tl) * 64 + d0)); \
        _Pragma("unroll") for (int i = 0; i < 2; ++i) { const int idx = tid + NTHREADS * i, e = idx >> 3, ch = idx & 7; \
            gv[i] = __builtin_nontemporal_load((const u32x4*)(VT + ((size_t)(bh_ * 128 + e)) * SEQ + s0_ + ch * 8)); \
            gc[i] = __builtin_nontemporal_load((const u32x4*)(CPREV + ((size_t)(bh_ * 128 + c_) * 128 + e) * 64 + ch * 8)); } \
        bs = BCUM[bh_ * SEQ + s0_ + lane]; li = LOGI[bh_ * SEQ + s0_ + lane]; mprev = CHS[2048 + bh_ * 128 + c_]; \
        npv = NPREV[(size_t)(bh_ * 128 + c_) * 64 + lane]; } while (0)
    if (F.bid < 1024) M3_ISSUE(F.bid);
    for (int unit = F.bid; unit < 1024; unit += F.G) {
        const int bh = unit & 7, c = unit >> 3, b = bh >> 2, h = bh & 3, s0 = c * 64, tok0 = b * SEQ + s0;
        const bf16_t* op = MLO + (size_t)(tok0 + tl) * 512 + h * 128 + (tid & 7) * 16;
        const u32x4 o0 = *(const u32x4*)op, o1 = *(const u32x4*)(op + 8);
        *(LAS u32x4*)(Qs + tl * 72 + d0) = gq; *(LAS u32x4*)(Ks + tl * 72 + d0) = gk;
#pragma unroll
        for (int i = 0; i < 2; ++i) {
            const int idx = tid + NTHREADS * i, e = idx >> 3, ch = idx & 7;
            *(LAS u32x4*)(VTs + e * 72 + ch * 8) = gv[i]; *(LAS u32x4*)(Cs + e * 72 + ch * 8) = gc[i];
        }
        if (wave == 0) {
            const float u = li - bs;
            float pm = u;
#pragma unroll
            for (int o = 1; o < 64; o <<= 1) { const float t = shfl_from(pm, (lane - o) & 63); if (lane >= o) pm = fmaxf(pm, t); }
            const float mm = fmaxf(mprev, pm);
            vu[lane] = u; vmm[lane] = mm; vdec[lane] = __expf(mprev - mm); vem[lane] = __expf(-(bs + mm));
        } else if (wave == 1) {
            vnp[lane] = npv;
        }
        if (unit + F.G < 1024) M3_ISSUE(unit + F.G);
        __syncthreads();
        { const u32x4 q = *(const LAS u32x4*)(Qs + tl * 72 + d0); const float dc = vdec[tl];
          u32x4 w; w.x = pk2(bf_lo(q.x) * dc, bf_hi(q.x) * dc); w.y = pk2(bf_lo(q.y) * dc, bf_hi(q.y) * dc); w.z = pk2(bf_lo(q.z) * dc, bf_hi(q.z) * dc); w.w = pk2(bf_lo(q.w) * dc, bf_hi(q.w) * dc);
          *(LAS u32x4*)(Qds + tl * 72 + d0) = w; }
        if (wave < 4) {
            const int jt = wave >> 1, st = wave & 1;
            f32x16 acc;
#pragma unroll
            for (int i = 0; i < 16; ++i) acc[i] = 0.f;
            const LAS bf16_t* ap = Qs + (32 * jt + r) * 72 + 8 * hh; const LAS bf16_t* bp = Ks + (32 * st + r) * 72 + 8 * hh;
#pragma unroll
            for (int ks = 0; ks < 4; ++ks) acc = MFMA32(*(const LAS bf16x8*)(ap + 16 * ks), *(const LAS bf16x8*)(bp + 16 * ks), acc);
            const int s = 32 * st + r; const float us = vu[s];
#pragma unroll
            for (int i = 0; i < 16; ++i) {
                const int j = 32 * jt + crow(i, hh);
                const float val = (s <= j) ? __expf(us - vmm[j]) * acc[i] : 0.f;
                Ws[j * 72 + s] = (bf16_t)(pk2(val, 0.f) & 0xffffu);
            }
        }
        __syncthreads();
        { const int jt = wave >> 2, et = wave & 3;
          f32x16 acc;
#pragma unroll
          for (int i = 0; i < 16; ++i) acc[i] = 0.f;
          const LAS bf16_t* a1 = Ws + (32 * jt + r) * 72 + 8 * hh; const LAS bf16_t* b1 = VTs + (32 * et + r) * 72 + 8 * hh;
          const LAS bf16_t* a2 = Qds + (32 * jt + r) * 72 + 8 * hh; const LAS bf16_t* b2 = Cs + (32 * et + r) * 72 + 8 * hh;
#pragma unroll
          for (int ks = 0; ks < 4; ++ks) acc = MFMA32(*(const LAS bf16x8*)(a1 + 16 * ks), *(const LAS bf16x8*)(b1 + 16 * ks), acc);
#pragma unroll
          for (int ks = 0; ks < 4; ++ks) acc = MFMA32(*(const LAS bf16x8*)(a2 + 16 * ks), *(const LAS bf16x8*)(b2 + 16 * ks), acc);
#pragma unroll
          for (int i = 0; i < 16; ++i) Hs[(32 * jt + crow(i, hh)) * 132 + 32 * et + r] = acc[i];
        }
        if (tid < 64) {
            float rs = 0.f, qn = 0.f;
#pragma unroll
            for (int q8 = 0; q8 < 8; ++q8) {
                const u32x4 v = *(const LAS u32x4*)(Ws + tid * 72 + 8 * q8);
                rs += (bf_lo(v.x) + bf_hi(v.x)) + (bf_lo(v.y) + bf_hi(v.y)) + (bf_lo(v.z) + bf_hi(v.z)) + (bf_lo(v.w) + bf_hi(v.w));
                const u32x4 q = *(const LAS u32x4*)(Qds + tid * 72 + 8 * q8);
                const LAS float* np = vnp + 8 * q8;
                qn += bf_lo(q.x) * np[0] + bf_hi(q.x) * np[1] + bf_lo(q.y) * np[2] + bf_hi(q.y) * np[3] + bf_lo(q.z) * np[4] + bf_hi(q.z) * np[5] + bf_lo(q.w) * np[6] + bf_hi(q.w) * np[7];
            }
            const float den = rs + qn;
            vhd[tid] = 1.f / fmaxf(fabsf(den), vem[tid]);
        }
        __syncthreads();
        { const int j = tl, e0 = (tid & 7) * 16; const float hd = vhd[j];
          f32x4 hv[4]; float ss = 0.f;
#pragma unroll
          for (int i = 0; i < 4; ++i) { hv[i] = *(const LAS f32x4*)(Hs + j * 132 + e0 + 4 * i) * hd; ss += (hv[i][0] * hv[i][0] + hv[i][1] * hv[i][1]) + (hv[i][2] * hv[i][2] + hv[i][3] * hv[i][3]); }
          ss += dpp_f(ss, 0); ss += dpp_f(ss, 1); ss += dpp_f(ss, 2);
          const float rstd = 1.f / sqrtf(ss * (1.f / 128.f) + EPS);
          const unsigned ow[8] = {o0.x, o0.y, o0.z, o0.w, o1.x, o1.y, o1.z, o1.w};
          unsigned res[8];
#pragma unroll
          for (int i = 0; i < 4; ++i) {
              const f32x4 g = *(const LAS f32x4*)(ng + e0 + 4 * i);
              const float oa = bf_lo(ow[2 * i]), ob = bf_hi(ow[2 * i]), oc = bf_lo(ow[2 * i + 1]), od = bf_hi(ow[2 * i + 1]);
              const float v0 = hv[i][0] * rstd * g[0] / (1.f + __expf(-oa)), v1 = hv[i][1] * rstd * g[1] / (1.f + __expf(-ob));
              const float v2 = hv[i][2] * rstd * g[2] / (1.f + __expf(-oc)), v3 = hv[i][3] * rstd * g[3] / (1.f + __expf(-od));
              res[2 * i] = pk2(v0, v1); res[2 * i + 1] = pk2(v2, v3);
          }
          bf16_t* yp = YMIX + (size_t)(tok0 + j) * 1024 + 512 + h * 128 + e0;
          u32x4 w0 = {res[0], res[1], res[2], res[3]}, w1 = {res[4], res[5], res[6], res[7]};
          *(u32x4*)yp = w0; *(u32x4*)(yp + 8) = w1;
        }
        __syncthreads();
    }
}

#undef M3_ISSUE
constexpr float AT_THR = 6.f;
constexpr int AT_STAGE = 36864, AT_K1 = 9216, AT_V = 18432, AT_SG_OFF = LDS_BYTES - 2048;
DI void attn_unit(const Ctx& F, int l, int bh, int qb, float lam) {
    const int tid = F.tid, lane = F.lane, wave = F.wave, c = wave >> 2, rg = wave & 3, r = lane & 31, hh = lane >> 5;
    const int b = bh >> 2, h = bh & 3;
    LAS unsigned char* L = F.lds;
    const bf16_t* Qg = (const bf16_t*)(F.ws + WS_Q); const bf16_t* Kg = (const bf16_t*)(F.ws + WS_K); const bf16_t* VTg = (const bf16_t*)(F.ws + WS_VTDA);
    bf16_t* YMIX = (bf16_t*)(F.ws + WS_XN);
    const int q0 = qb * 128 + rg * 32;
    bf16x8 qf[4];
    { const bf16_t* qp = Qg + ((size_t)((bh * 2 + c) * SEQ) + q0 + r) * 64 + 8 * hh;
#pragma unroll
      for (int ks = 0; ks < 4; ++ks) qf[ks] = *(const bf16x8*)(qp + 16 * ks); }
    const int ntile = 2 * qb + 2, my_n = (rg < 2) ? ntile - 1 : ntile;
    const int krow = tid >> 3, kch = tid & 7;
    const bf16_t* k0p = Kg + ((size_t)((bh * 2 + 0) * SEQ) + krow) * 64 + kch * 8;
    const bf16_t* k1p = Kg + ((size_t)((bh * 2 + 1) * SEQ) + krow) * 64 + kch * 8;
    const bf16_t* v0p = VTg + ((size_t)(bh * 128 + krow)) * SEQ + kch * 8;
    const bf16_t* v1p = VTg + ((size_t)(bh * 128 + 64 + krow)) * SEQ + kch * 8;
    const int kdst = krow * 144 + kch * 16;
    u32x4 pk0, pk1, pv0, pv1;
    pk0 = *(const u32x4*)k0p; pk1 = *(const u32x4*)k1p; pv0 = *(const u32x4*)v0p; pv1 = *(const u32x4*)v1p;
    *(LAS u32x4*)(L + kdst) = pk0; *(LAS u32x4*)(L + AT_K1 + kdst) = pk1; *(LAS u32x4*)(L + AT_V + kdst) = pv0; *(LAS u32x4*)(L + AT_V + 64 * 144 + kdst) = pv1;
    if (ntile > 1) { pk0 = *(const u32x4*)(k0p + 64 * 64); pk1 = *(const u32x4*)(k1p + 64 * 64); pv0 = *(const u32x4*)(v0p + 64); pv1 = *(const u32x4*)(v1p + 64); }
    __syncthreads();
    f32x16 o[4];
#pragma unroll
    for (int dt = 0; dt < 4; ++dt)
#pragma unroll
        for (int i = 0; i < 16; ++i) o[dt][i] = 0.f;
    float m_run = -30.f, l_run = 0.f;
    bf16x8 pb[4];
#pragma unroll
    for (int i = 0; i < 4; ++i) pb[i] = (bf16x8){0, 0, 0, 0, 0, 0, 0, 0};
    const int kap = (r & ~12) | ((r & 4) << 1) | ((r & 8) >> 1);
    const int koff = c * AT_K1 + kap * 144 + 16 * hh, voff = AT_V + r * 144 + 16 * hh;
#define AT_STAGE_STEP(tw) do { if ((tw) < ntile) { LAS unsigned char* S2 = L + ((tw) & 1) * AT_STAGE; \
        *(LAS u32x4*)(S2 + kdst) = pk0; *(LAS u32x4*)(S2 + AT_K1 + kdst) = pk1; *(LAS u32x4*)(S2 + AT_V + kdst) = pv0; *(LAS u32x4*)(S2 + AT_V + 64 * 144 + kdst) = pv1; \
        if ((tw) + 1 < ntile) { const size_t ko = (size_t)((tw) + 1) * 64 * 64, vo = (size_t)((tw) + 1) * 64; \
            pk0 = *(const u32x4*)(k0p + ko); pk1 = *(const u32x4*)(k1p + ko); pv0 = *(const u32x4*)(v0p + vo); pv1 = *(const u32x4*)(v1p + vo); } } } while (0)
    if (c == 1) __syncthreads();
    for (int t = 0; t < ntile; ++t) {
        LAS unsigned char* S = L + (t & 1) * AT_STAGE;
        if (c == 1) AT_STAGE_STEP(t + 1);
        {
            f32x16 p0, p1;
            const float ninit = (t < my_n) ? -m_run : -1e30f;
#pragma unroll
            for (int i = 0; i < 16; ++i) { p0[i] = ninit; p1[i] = ninit; }
#pragma unroll
            for (int ks = 0; ks < 4; ++ks) { const bf16x8 ka = *(const LAS bf16x8*)(S + koff + 32 * ks); p0 = MFMA32(ka, qf[ks], p0); }
#pragma unroll
            for (int ks = 0; ks < 4; ++ks) { const bf16x8 kb = *(const LAS bf16x8*)(S + koff + 32 * 144 + 32 * ks); p1 = MFMA32(kb, qf[ks], p1); }
            float mx0 = max3f(p0[0], p0[1], p0[2]);
#pragma unroll
            for (int i = 3; i < 15; i += 2) mx0 = max3f(mx0, p0[i], p0[i + 1]);
            mx0 = fmaxf(mx0, p0[15]);
            float ps = 0.f;
#pragma unroll
            for (int i = 0; i < 16; ++i) { p0[i] = __builtin_amdgcn_exp2f(p0[i]); ps += p0[i]; }
            float mx = max3f(mx0, p1[0], p1[1]);
#pragma unroll
            for (int i = 2; i < 16; i += 2) mx = max3f(mx, p1[i], p1[i + 1]);
            mx = half_max(mx);
            if (__any(mx > AT_THR)) {
                const float delta = fmaxf(mx, 0.f);
                const float alpha = __builtin_amdgcn_exp2f(-delta);
                m_run += delta; l_run *= alpha; ps *= alpha;
#pragma unroll
                for (int i = 0; i < 16; ++i) { p0[i] *= alpha; p1[i] -= delta; }
#pragma unroll
                for (int dt = 0; dt < 4; ++dt)
#pragma unroll
                    for (int i = 0; i < 16; ++i) o[dt][i] *= alpha;
            }
#pragma unroll
            for (int i = 0; i < 16; ++i) { p1[i] = __builtin_amdgcn_exp2f(p1[i]); ps += p1[i]; }
            l_run += ps;
            { u32x4 w;
              w.x = pk2(p0[0], p0[1]); w.y = pk2(p0[2], p0[3]); w.z = pk2(p0[4], p0[5]); w.w = pk2(p0[6], p0[7]); pb[0] = __builtin_bit_cast(bf16x8, w);
              w.x = pk2(p0[8], p0[9]); w.y = pk2(p0[10], p0[11]); w.z = pk2(p0[12], p0[13]); w.w = pk2(p0[14], p0[15]); pb[1] = __builtin_bit_cast(bf16x8, w);
              w.x = pk2(p1[0], p1[1]); w.y = pk2(p1[2], p1[3]); w.z = pk2(p1[4], p1[5]); w.w = pk2(p1[6], p1[7]); pb[2] = __builtin_bit_cast(bf16x8, w);
              w.x = pk2(p1[8], p1[9]); w.y = pk2(p1[10], p1[11]); w.z = pk2(p1[12], p1[13]); w.w = pk2(p1[14], p1[15]); pb[3] = __builtin_bit_cast(bf16x8, w); }
            asm volatile("" : "+v"(pb[0]), "+v"(pb[1]), "+v"(pb[2]), "+v"(pb[3]), "+v"(l_run));
        }
        __syncthreads();
        if (c == 0) AT_STAGE_STEP(t + 1);
#pragma unroll
        for (int st = 0; st < 4; ++st)
#pragma unroll
            for (int dt = 0; dt < 4; ++dt) {
                const bf16x8 va = *(const LAS bf16x8*)(S + voff + dt * 32 * 144 + 32 * st);
                o[dt] = MFMA32(va, pb[st], o[dt]);
            }
        __syncthreads();
    }
    if (c == 0) __syncthreads();
#undef AT_STAGE_STEP
    const float inv = 1.f / half_sum(l_run);
    LAS float* X = (LAS float*)L;
    if (c == 1) {
#pragma unroll
        for (int dt = 0; dt < 4; ++dt)
#pragma unroll
            for (int i = 0; i < 16; ++i) X[(rg * 128 + 32 * dt + crow(i, hh)) * 32 + r] = o[dt][i] * inv;
    }
    __syncthreads();
    if (c == 0) {
        float ss = 0.f;
#pragma unroll
        for (int dt = 0; dt < 4; ++dt)
#pragma unroll
            for (int i = 0; i < 16; ++i) { const float v = o[dt][i] * inv - lam * X[(rg * 128 + 32 * dt + crow(i, hh)) * 32 + r]; o[dt][i] = v; ss += v * v; }
        ss = half_sum(ss);
        const float li = (l == 0) ? 0.2f : 0.35550907f;
        const float rstd = (1.f - li) / sqrtf(ss * (1.f / 128.f) + EPS);
        const LAS float* sg = (const LAS float*)(F.lds + AT_SG_OFF);
        bf16_t* yp = YMIX + (size_t)(b * SEQ + q0 + r) * 1024 + h * 128;
#pragma unroll
        for (int dt = 0; dt < 4; ++dt)
#pragma unroll
            for (int g4 = 0; g4 < 4; ++g4) {
                const int d = 32 * dt + 8 * g4 + 4 * hh;
                const f32x4 g = *(const LAS f32x4*)(sg + d);
                u32x2 w; w.x = pk2(o[dt][4 * g4] * rstd * g[0], o[dt][4 * g4 + 1] * rstd * g[1]); w.y = pk2(o[dt][4 * g4 + 2] * rstd * g[2], o[dt][4 * g4 + 3] * rstd * g[3]);
                *(u32x2*)(yp + d) = w;
            }
    }
    __syncthreads();
}

DI void attn_m3_phase(const Ctx& F, int l) {
    const float* lv = F.da_lambda + (size_t)l * 256;
    const float s1 = wave_sum_dpp(lv[F.lane] * lv[64 + F.lane]), s2 = wave_sum_dpp(lv[128 + F.lane] * lv[192 + F.lane]);
    const float li = (l == 0) ? 0.2f : 0.35550907f;
    const float lam = expf(s1) - expf(s2) + li;
    if (F.tid < 128) ((LAS float*)(F.lds + AT_SG_OFF))[F.tid] = F.da_subln_g[(size_t)l * 128 + F.tid];
    __syncthreads();
    for (int rep = 0; rep < D_AT; ++rep)
    for (int p = F.bid; p < 256; p += F.G) {
        const int bh = p & 7, i = p >> 3;
#if EN_AT
        attn_unit(F, l, bh, 63 - i, lam);
        attn_unit(F, l, bh, i, lam);
#endif
    }
#if EN_M3
    for (int rep = 0; rep < D_M3; ++rep) m3_phase(F, l);
#endif
}


#define XB_TMO      128
#define XB_XCNT(j)  (256  + 64 * (j))
#define XB_XSUB(j)  (1280 + 64 * (j))
#define XB_XGEN(j)  (2304 + 64 * (j))
#define XB_TOP      3328
#define XB_TOPGEN   3392
#define XCD_BAR_WORDS 3456
#define XB_SPIN_CAP (1u << 22)
DI unsigned xb_ld(unsigned* p)              { return __hip_atomic_load(p, __ATOMIC_RELAXED, __HIP_MEMORY_SCOPE_AGENT); }
DI unsigned xb_add(unsigned* p, unsigned v) { return __hip_atomic_fetch_add(p, v, __ATOMIC_RELAXED, __HIP_MEMORY_SCOPE_AGENT); }
DI unsigned xb_xcc_id() { return (unsigned)__builtin_amdgcn_s_getreg((3 << 11) | 20) & 0xFu; }
#define XB_SPIN(cond, bar) do { unsigned _sp = 0; while (cond) { __builtin_amdgcn_s_sleep(1); \
    if ((++_sp & 255u) == 0u) { if (xb_ld(&(bar)[XB_TMO])) break; if (_sp > XB_SPIN_CAP) { atomicAdd(&(bar)[XB_TMO], 1u); break; } } } } while (0)
struct XcdBarrier { unsigned* bar; unsigned x; volatile LAS unsigned* st; };
DI XcdBarrier xcd_barrier_post(unsigned* bar, volatile LAS unsigned* st) {
    XcdBarrier b; b.bar = bar; b.x = xb_xcc_id(); b.st = st;
    if (threadIdx.x == 0) (void)xb_add(&bar[XB_XCNT(b.x)], 1u);
    return b;
}
DI void xcd_barrier_complete(unsigned* bar, unsigned x, unsigned& nloc, unsigned& nx) {
    const unsigned G = gridDim.x * gridDim.y * gridDim.z;
    unsigned sum, cnt, mine, sp = 0u;
    for (;;) {
        sum = 0u; cnt = 0u; mine = 0u;
#pragma unroll
        for (unsigned j = 0; j < 16; ++j) { const unsigned c = xb_ld(&bar[XB_XCNT(j)]); sum += c; cnt += (c > 0u) ? 1u : 0u; mine = (j == x) ? c : mine; }
        if (sum == G) break;
        __builtin_amdgcn_s_sleep(1);
        if ((++sp & 255u) == 0u) { if (xb_ld(&bar[XB_TMO])) break; if (sp > XB_SPIN_CAP) { atomicAdd(&bar[XB_TMO], 1u); break; } }
    }
    nloc = mine > 0u ? mine : 1u; nx = cnt > 0u ? cnt : 1u;
}
DI void xcd_barrier(const XcdBarrier& b) {
    asm volatile("s_waitcnt vmcnt(0)" ::: "memory");
    __syncthreads();
    if (threadIdx.x == 0) {
        unsigned* bar = b.bar;
        __builtin_amdgcn_s_waitcnt(0);
        unsigned nloc = b.st[0], nx = b.st[1];
        if (nloc == 0u) { xcd_barrier_complete(bar, b.x, nloc, nx); b.st[0] = nloc; b.st[1] = nx; }
        const unsigned old = xb_add(&bar[XB_XSUB(b.x)], 1u);
        const unsigned gen = old / nloc;
        if (old + 1u == (gen + 1u) * nloc) {
            __builtin_amdgcn_fence(__ATOMIC_RELEASE, "agent");
            asm volatile("s_waitcnt vmcnt(0)" ::: "memory");
            const unsigned og = xb_add(&bar[XB_TOP], 1u);
            const unsigned tg = og / nx;
            if (og + 1u == (tg + 1u) * nx) xb_add(&bar[XB_TOPGEN], 1u);
            else XB_SPIN(xb_ld(&bar[XB_TOPGEN]) == tg, bar);
            __builtin_amdgcn_fence(__ATOMIC_ACQUIRE, "agent");
            xb_add(&bar[XB_XGEN(b.x)], 1u);
            asm volatile("s_waitcnt vmcnt(0)" ::: "memory");
        } else {
            XB_SPIN(xb_ld(&bar[XB_XGEN(b.x)]) == gen, bar);
            __builtin_amdgcn_fence(__ATOMIC_ACQUIRE, "agent");
            asm volatile("s_waitcnt vmcnt(0)" ::: "memory");
        }
    }
    __syncthreads();
}

__global__ void __launch_bounds__(NTHREADS, 2) fwd_kernel(Args args) {
    extern __shared__ __attribute__((aligned(16))) unsigned char lds_raw[];
    unsigned char* ws = args.ws;
    bf16_t* XN = (bf16_t*)(ws + WS_XN); bf16_t* ACT = (bf16_t*)(ws + WS_A); bf16_t* Y = (bf16_t*)(ws + WS_Y);
    volatile LAS unsigned* bst = (volatile LAS unsigned*)((LAS unsigned char*)lds_raw + LDS_BYTES - 64);
    if (threadIdx.x < 2) bst[threadIdx.x] = 0u;
    __syncthreads();
    XcdBarrier xbar = xcd_barrier_post((unsigned*)(args.ws + WS_BAR), bst);
    int probe_rep = 0;
    for (int ph = args.ph_lo; ph < args.ph_hi; ++ph) {
        Ctx F;
        F.lds = (LAS unsigned char*)lds_raw;
        { int t = threadIdx.x; asm volatile("" : "+v"(t)); F.tid = t; }
        F.lane = F.tid & 63; F.wave = __builtin_amdgcn_readfirstlane(F.tid >> 6);
        { int bb = blockIdx.x; asm volatile("" : "+s"(bb)); F.bid = bb; }
        F.G = gridDim.x;
        F.x = args.in[0]; F.ffn_w_in = args.in[1]; F.ffn_w_out = args.in[2]; F.norm_g = args.in[3]; F.mix_w_in = args.in[4]; F.mix_w_out = args.in[5];
        F.da_lambda = args.in[6]; F.da_subln_g = args.in[7]; F.conv_w = args.in[8]; F.conv_b = args.in[9]; F.gate_b = args.in[10]; F.ml_norm_g = args.in[11];
        F.out = args.out; F.ws = args.ws;
        if (ph == 0) {
#if EN_PRO
            for (int rep = 0; rep < D_PRO; ++rep) prologue(F);
#endif
        } else {
            const int l = (ph - 1) / 12, k = (ph - 1) % 12;
            const float* ng = F.norm_g + (size_t)l * 6 * D;
            if (k == 0 || k == 9) {
                const int s = (k == 0) ? 0 : 1;
                pg8::Gemm g{XN, (const bf16_t*)(ws + WS_WIN) + (size_t)(l * 2 + s) * 2 * DFF * D, M, 2 * DFF, D};
                pg8::StaticOrder S; S.init(M, 2 * DFF, F.G, F.bid);
                pg8::EpiSwiglu E{ACT};
#if EN_G1
                for (int rep = 0; rep < D_G1; ++rep) pg8::gemm_phase<pg8::EpiSwiglu>(F.lds, F.tid, g, S, E);
#endif
                {
                    const int nun = (M / 256) * (2 * DFF / 256), rem = nun % F.G, first = rem ? rem : 0, nidle = F.G - first;
                    if (F.bid >= first) {
                        LAS float* scr = (LAS float*)(F.lds + F.wave * 16384);
                        const int worker = (F.bid - first) * 8 + F.wave, nworkers = nidle * 8;
                        if (l == 0 && k == 0) conv_group<1>(F, worker, nworkers, scr);
                        else if (l == 0 && k == 9) conv_group<2>(F, worker, nworkers, scr);
                        else if (l == 1 && k == 0) conv_group<3>(F, worker, nworkers, scr);
                    }
                }
            } else if (k == 1 || k == 10 || k == 7) {
                pg8::Gemm g;
                if (k == 7) g = pg8::Gemm{XN, (const bf16_t*)(ws + WS_WMIXOUT) + (size_t)l * D * D, M, D, D};
                else g = pg8::Gemm{ACT, (const bf16_t*)(ws + WS_WOUT) + (size_t)(l * 2 + (k == 1 ? 0 : 1)) * D * DFF, M, D, DFF};
                pg8::StaticOrder S; S.init(M, D, F.G, F.bid);
                pg8::EpiBf16 E{Y, D};
#if EN_G2
                for (int rep = 0; rep < D_G2; ++rep) pg8::gemm_phase<pg8::EpiBf16>(F.lds, F.tid, g, S, E);
#endif
            } else if (k == 2 || k == 8 || k == 11) {
                const float* xsrc = (l == 0 && k == 2) ? F.x : F.out;
                const float* gpost = ng + (k == 2 ? 1 : (k == 8 ? 3 : 5)) * D;
                const float coef = (k == 8) ? 1.f : 0.5f;
                const float* gpre = (k == 2) ? ng + 2 * D : (k == 8 ? ng + 4 * D : (l + 1 < NL ? F.norm_g + (size_t)(l + 1) * 6 * D : nullptr));
                const bool wg = (k == 2);
#if EN_N
                norm_phase(F, xsrc, F.out, Y, gpost, coef, gpre, XN, wg ? F.mix_w_in + (size_t)l * D * MIXN + 3072 : nullptr, F.gate_b + l * 8, (float*)(ws + WS_GATES));
#endif
            } else if (k == 3) {
                const bf16_t* Wt = (const bf16_t*)(ws + WS_WMIXIN) + (size_t)l * 3072 * D;
                { pg8::Gemm g{XN, Wt + (size_t)2048 * D, M, 1024, D}; pg8::StaticOrder S; S.init(M, 1024, F.G, F.bid);
                  pg8::EpiVT E{(bf16_t*)(ws + WS_VTDA), (bf16_t*)(ws + WS_VTML)};
#if EN_G3A
                  for (int rep = 0; rep < D_G3; ++rep) pg8::gemm_phase<pg8::EpiVT>(F.lds, F.tid, g, S, E);
#endif
                }
                { pg8::Gemm g{XN, Wt, M, 2048, D}; pg8::StaticOrder S; S.init(M, 2048, F.G, F.bid);
                  pg8::EpiMix E{(bf16_t*)(ws + WS_Q), (bf16_t*)(ws + WS_K), (bf16_t*)(ws + WS_MLQK), (bf16_t*)(ws + WS_MLO)};
#if EN_G3B
                  for (int rep = 0; rep < D_G3; ++rep) pg8::gemm_phase<pg8::EpiMix>(F.lds, F.tid, g, S, E);
#endif
                }
            } else if (k == 4) {
#if EN_M1
                for (int rep = 0; rep < D_M1; ++rep) m1_phase(F, l);
#endif
            } else if (k == 5) {
#if EN_M2
                for (int rep = 0; rep < D_M2; ++rep) m2_phase(F, l);
#endif
            } else if (k == 6) {
                attn_m3_phase(F, l);
            }
        }
        if (PROBE_MASK) {
            const int kk = (ph == 0) ? 12 : (ph - 1) % 12;
            if (((PROBE_MASK >> kk) & 1) && !probe_rep) { probe_rep = 1; --ph; } else probe_rep = 0;
        }
        if (ph + 1 < args.ph_hi) {
            if (args.ph_hi > 4096) cg::this_grid().sync();
            else xcd_barrier(xbar);
        }
    }
}

constexpr int NPHASES = 1 + 12 * NL;

extern "C" void kernel_launch(void* const* d_in, const int* in_sizes, int n_in, void* d_out, int out_size, void* d_ws, size_t ws_size, hipStream_t stream) {
    static int grid = 0;
    if (grid == 0) {
        if (n_in != 12 || in_sizes[0] != M * D || out_size != M * D || ws_size < WS_END) {
            fprintf(stderr, "kernel_launch: unexpected shapes: n_in %d in0 %d out %d ws %zu (need %zu)\n", n_in, n_in > 0 ? in_sizes[0] : -1, out_size, ws_size, (size_t)WS_END); grid = -1; return; }
        int dev = 0, cus = 0, per_cu = 0;
        hipGetDevice(&dev);
        hipDeviceGetAttribute(&cus, hipDeviceAttributeMultiprocessorCount, dev);
        if (hipFuncSetAttribute((const void*)fwd_kernel, hipFuncAttributeMaxDynamicSharedMemorySize, LDS_BYTES) != hipSuccess) { fprintf(stderr, "kernel_launch: hipFuncSetAttribute failed\n"); grid = -1; return; }
        if (hipOccupancyMaxActiveBlocksPerMultiprocessor(&per_cu, (const void*)fwd_kernel, NTHREADS, LDS_BYTES) != hipSuccess || per_cu < 1) { fprintf(stderr, "kernel_launch: occupancy query says %d\n", per_cu); per_cu = 1; }
        (void)hipGetLastError();
        grid = cus * 1;
        if (grid <= 0) grid = 256;
    }
    if (grid < 0) return;
    if (hipMemsetAsync((char*)d_ws + WS_BAR, 0, 16384, stream) != hipSuccess) { fprintf(stderr, "kernel_launch: memset failed\n"); return; }
    Args a{};
    for (int i = 0; i < 12; ++i) a.in[i] = (const float*)d_in[i];
    a.out = (float*)d_out; a.ws = (unsigned char*)d_ws;
#if ONE_LAUNCH
    a.ph_lo = 0; a.ph_hi = NPHASES;
    void* kargs[] = {&a};
    hipError_t e = hipLaunchCooperativeKernel((const void*)fwd_kernel, dim3(grid), dim3(NTHREADS), kargs, LDS_BYTES, stream);
    if (e != hipSuccess) fprintf(stderr, "kernel_launch: cooperative launch failed: %s (grid %d)\n", hipGetErrorString(e), grid);
#else
    for (int ph = 0; ph < NPHASES; ++ph) {
        a.ph_lo = ph; a.ph_hi = ph + 1;
        hipLaunchKernelGGL(fwd_kernel, dim3(grid), dim3(NTHREADS), LDS_BYTES, stream, a);
    }
#endif
}
```
